# Optimizing an MI355X kernel written in HIP

```python
import jax, jax.numpy as jnp
from jax import lax
import numpy as np

D_MODEL = 2048
BATCH = 2
SEQ = 8192
DEPTH = 1

MOBA_HEADS = 8
MOBA_HEAD_DIM = 128
MOBA_WIDTH = MOBA_HEADS * MOBA_HEAD_DIM
MOBA_BLOCK = 256
MOBA_TOPK = 3
MOBA_Q_CHUNK = 32

MLA_HEADS = 8
MLA_NOPE_DIM = 128
MLA_ROPE_DIM = 64
MLA_V_DIM = 128
MLA_Q_RANK = 512
MLA_KV_RANK = 512
MLA_WIDTH = MLA_HEADS * MLA_V_DIM
MLA_Q_CHUNK = 128
ROPE_THETA = 10000.0

MIX_WIDTH = MOBA_WIDTH + MLA_WIDTH
IN_COLS = 3 * MOBA_WIDTH + MLA_Q_RANK + MLA_KV_RANK + MLA_ROPE_DIM

N_EXPERTS = 32
TOP_K = 4
D_FF = D_MODEL
SWIGLU_LIMIT = 7.0
SWIGLU_ALPHA = 1.702
EXPERT_BLOCK = 256

NORM_EPS = 1e-5

kernel_name = "hybrid_moba_mla_moe_block"


def rms_norm(x, g):
    xf = x.astype(jnp.float32)
    y = xf * lax.rsqrt(jnp.mean(xf * xf, axis=-1, keepdims=True) + NORM_EPS)
    return (y * g.astype(jnp.float32)).astype(x.dtype)


def alibi_slopes(n_heads):
    return jnp.asarray(np.array([2.0 ** (-8.0 * (h + 1) / n_heads) for h in range(n_heads)], np.float32))


def rope_cos_sin(seq_len):
    inv = 1.0 / (ROPE_THETA ** (jnp.arange(0, MLA_ROPE_DIM, 2, dtype=jnp.float32) / MLA_ROPE_DIM))
    ang = jnp.arange(seq_len, dtype=jnp.float32)[:, None] * inv[None, :]
    ang = jnp.concatenate([ang, ang], axis=-1)
    return jnp.cos(ang), jnp.sin(ang)


def apply_rope(x, cos, sin):
    half = x.shape[-1] // 2
    rot = jnp.concatenate([-x[..., half:], x[..., :half]], axis=-1)
    return (x * cos + rot * sin).astype(x.dtype)


def moba_attention(q, k, v):
    B, H, S, Dh = q.shape
    n_blk = -(-S // MOBA_BLOCK)
    s_pad = n_blk * MOBA_BLOCK
    pad = ((0, 0), (0, 0), (0, s_pad - S), (0, 0))
    kp = jnp.pad(k, pad)
    vp = jnp.pad(v, pad)
    kb = kp.reshape(B, H, n_blk, MOBA_BLOCK, Dh)
    vb = vp.reshape(B, H, n_blk, MOBA_BLOCK, Dh)
    k_mean = jnp.mean(kb.astype(jnp.float32), axis=3).astype(k.dtype)
    k_sel = min(MOBA_TOPK, n_blk)
    slopes = alibi_slopes(H)
    scale = Dh ** -0.5
    bi = jnp.arange(B)[:, None, None, None]
    hi = jnp.arange(H)[None, :, None, None]
    key_off = jnp.arange(MOBA_BLOCK)
    blk_ids = jnp.arange(n_blk)

    def chunk(c):
        t0 = c * MOBA_Q_CHUNK
        q_c = lax.dynamic_slice_in_dim(q, t0, MOBA_Q_CHUNK, axis=2)
        t = t0 + jnp.arange(MOBA_Q_CHUNK)
        cur = t0 // MOBA_BLOCK
        gate = jnp.einsum('bhqd,bhnd->bhqn', q_c, k_mean).astype(jnp.float32)
        gate = jnp.where(blk_ids < cur, gate, -jnp.inf)
        _, sel = lax.top_k(gate, k_sel)
        sel_valid = sel < cur
        k_g = kb[bi, hi, sel]
        v_g = vb[bi, hi, sel]
        s_sel = jnp.einsum('bhqd,bhqjkd->bhqjk', q_c, k_g).astype(jnp.float32) * scale
        pos_sel = sel[..., None] * MOBA_BLOCK + key_off
        dist_sel = t[None, None, :, None, None] - pos_sel
        s_sel = s_sel - slopes[None, :, None, None, None] * dist_sel
        s_sel = jnp.where(sel_valid[..., None], s_sel, -jnp.inf)
        k_own = lax.dynamic_slice_in_dim(kp, cur * MOBA_BLOCK, MOBA_BLOCK, axis=2)
        v_own = lax.dynamic_slice_in_dim(vp, cur * MOBA_BLOCK, MOBA_BLOCK, axis=2)
        s_own = jnp.einsum('bhqd,bhkd->bhqk', q_c, k_own).astype(jnp.float32) * scale
        dist_own = t[:, None] - (cur * MOBA_BLOCK + key_off)[None, :]
        s_own = s_own - slopes[None, :, None, None] * dist_own
        s_own = jnp.where(dist_own >= 0, s_own, -jnp.inf)
        n_sel_keys = k_sel * MOBA_BLOCK
        scores = jnp.concatenate(
            [s_sel.reshape(B, H, MOBA_Q_CHUNK, n_sel_keys), s_own], axis=-1)
        p = jax.nn.softmax(scores, axis=-1).astype(v.dtype)
        p_sel = p[..., :n_sel_keys].reshape(B, H, MOBA_Q_CHUNK, k_sel, MOBA_BLOCK)
        p_own = p[..., n_sel_keys:]
        return (jnp.einsum('bhqjk,bhqjkd->bhqd', p_sel, v_g)
                + jnp.einsum('bhqk,bhkd->bhqd', p_own, v_own))

    out = lax.map(chunk, jnp.arange(S // MOBA_Q_CHUNK))
    return out.transpose(1, 2, 0, 3, 4).reshape(B, H, S, Dh)


def mla_attention(q_nope, q_rope, k_nope, k_rope, v):
    B, H, S, _ = q_nope.shape
    scale = (MLA_NOPE_DIM + MLA_ROPE_DIM) ** -0.5
    key_pos = jnp.arange(S)

    def chunk(c):
        t0 = c * MLA_Q_CHUNK
        qn = lax.dynamic_slice_in_dim(q_nope, t0, MLA_Q_CHUNK, axis=2)
        qr = lax.dynamic_slice_in_dim(q_rope, t0, MLA_Q_CHUNK, axis=2)
        s = (jnp.einsum('bhqd,bhkd->bhqk', qn, k_nope)
             + jnp.einsum('bhqd,bkd->bhqk', qr, k_rope)).astype(jnp.float32) * scale
        t = t0 + jnp.arange(MLA_Q_CHUNK)
        s = jnp.where(key_pos[None, :] <= t[:, None], s, -jnp.inf)
        p = jax.nn.softmax(s, axis=-1).astype(v.dtype)
        return jnp.einsum('bhqk,bhkd->bhqd', p, v)

    out = lax.map(chunk, jnp.arange(S // MLA_Q_CHUNK))
    return out.transpose(1, 2, 0, 3, 4).reshape(B, H, S, MLA_V_DIM)


def token_mixer(h, w_in, moba_out_g, q_a_norm_g, kv_a_norm_g, w_uq, w_ukv, mla_out_g, w_o):
    B, S, _ = h.shape
    proj = h @ w_in
    cuts = [MOBA_WIDTH, 2 * MOBA_WIDTH, 3 * MOBA_WIDTH,
            3 * MOBA_WIDTH + MLA_Q_RANK, 3 * MOBA_WIDTH + MLA_Q_RANK + MLA_KV_RANK]
    q_m, k_m, v_m, c_q, c_kv, k_r = jnp.split(proj, cuts, axis=-1)

    def heads(t, n):
        return t.reshape(B, S, n, -1).transpose(0, 2, 1, 3)

    o_moba = moba_attention(heads(q_m, MOBA_HEADS), heads(k_m, MOBA_HEADS), heads(v_m, MOBA_HEADS))
    o_moba = o_moba.transpose(0, 2, 1, 3).reshape(B, S, MOBA_WIDTH)

    cos, sin = rope_cos_sin(S)
    q_full = (rms_norm(c_q, q_a_norm_g) @ w_uq).reshape(B, S, MLA_HEADS, MLA_NOPE_DIM + MLA_ROPE_DIM)
    q_nope = q_full[..., :MLA_NOPE_DIM]
    q_rope = apply_rope(q_full[..., MLA_NOPE_DIM:], cos[:, None, :], sin[:, None, :])
    kv = (rms_norm(c_kv, kv_a_norm_g) @ w_ukv).reshape(B, S, MLA_HEADS, MLA_NOPE_DIM + MLA_V_DIM)
    k_nope = kv[..., :MLA_NOPE_DIM]
    v_mla = kv[..., MLA_NOPE_DIM:]
    k_rope = apply_rope(k_r, cos, sin)
    o_mla = mla_attention(q_nope.transpose(0, 2, 1, 3), q_rope.transpose(0, 2, 1, 3),
                          k_nope.transpose(0, 2, 1, 3), k_rope, v_mla.transpose(0, 2, 1, 3))
    o_mla = o_mla.transpose(0, 2, 1, 3).reshape(B, S, MLA_WIDTH)

    o = jnp.concatenate([rms_norm(o_moba, moba_out_g), rms_norm(o_mla, mla_out_g)], axis=-1)
    return o @ w_o


def moe_ffn(h, w_router, b_router, w1, b1, w2, b2):
    B, S, D = h.shape
    T = B * S
    xt = h.reshape(T, D)
    logits = (xt @ w_router + b_router).astype(jnp.float32)
    top_val, top_idx = lax.top_k(logits, TOP_K)
    gates = jax.nn.softmax(top_val, axis=-1).astype(h.dtype)

    A = T * TOP_K
    n_blocks = -(-A // EXPERT_BLOCK) + N_EXPERTS
    e_flat = top_idx.reshape(-1).astype(jnp.int32)
    g_flat = gates.reshape(-1)
    tok_flat = jnp.arange(A, dtype=jnp.int32) // TOP_K
    order = jnp.argsort(e_flat)
    e_sorted = e_flat[order]
    tok_sorted = tok_flat[order]
    g_sorted = g_flat[order]
    counts = jnp.zeros((N_EXPERTS,), jnp.int32).at[e_flat].add(1)
    start = jnp.cumsum(counts) - counts
    padded = ((counts + EXPERT_BLOCK - 1) // EXPERT_BLOCK) * EXPERT_BLOCK
    pad_end = jnp.cumsum(padded)
    pad_start = pad_end - padded
    dest = pad_start[e_sorted] + (jnp.arange(A, dtype=jnp.int32) - start[e_sorted])
    n_rows = n_blocks * EXPERT_BLOCK
    src = jnp.full((n_rows,), T, jnp.int32).at[dest].set(tok_sorted)
    block_expert = jnp.clip(
        jnp.searchsorted(pad_end, jnp.arange(n_blocks, dtype=jnp.int32) * EXPERT_BLOCK, side='right'),
        0, N_EXPERTS - 1).astype(jnp.int32)
    x_pad = jnp.concatenate([xt, jnp.zeros((1, D), xt.dtype)], axis=0)
    x_buf = x_pad[src].reshape(n_blocks, EXPERT_BLOCK, D)

    def expert_block(args):
        xb, e = args
        hb = xb @ w1[e] + b1[e]
        glu = jnp.minimum(hb[:, :D_FF], SWIGLU_LIMIT)
        lin = jnp.clip(hb[:, D_FF:], -SWIGLU_LIMIT, SWIGLU_LIMIT)
        act = glu * jax.nn.sigmoid(SWIGLU_ALPHA * glu) * (lin + 1.0)
        return act @ w2[e] + b2[e]

    y_buf = lax.map(expert_block, (x_buf, block_expert)).reshape(n_rows, D)
    y_assign = y_buf[dest] * g_sorted[:, None]
    out = jax.ops.segment_sum(y_assign, tok_sorted, num_segments=T)
    return out.reshape(B, S, D).astype(h.dtype)


def setup_inputs(seed: int = 0) -> dict:
    key = jax.random.key(seed)
    ks = jax.random.split(key, 20)
    f32 = jnp.float32

    def nrm(k, shape, fan_in):
        return jax.random.normal(k, shape, f32) * (fan_in ** -0.5)

    def gain(k, shape):
        return 1.0 + 0.05 * jax.random.normal(k, shape, f32)

    L = DEPTH
    return {
        "x": jax.random.normal(ks[0], (BATCH, SEQ, D_MODEL), f32),
        "norm_attn_g": gain(ks[1], (L, D_MODEL)),
        "w_in": nrm(ks[2], (L, D_MODEL, IN_COLS), D_MODEL),
        "moba_out_g": gain(ks[3], (L, MOBA_WIDTH)),
        "q_a_norm_g": gain(ks[4], (L, MLA_Q_RANK)),
        "kv_a_norm_g": gain(ks[5], (L, MLA_KV_RANK)),
        "w_uq": nrm(ks[6], (L, MLA_Q_RANK, MLA_HEADS * (MLA_NOPE_DIM + MLA_ROPE_DIM)), MLA_Q_RANK),
        "w_ukv": nrm(ks[7], (L, MLA_KV_RANK, MLA_HEADS * (MLA_NOPE_DIM + MLA_V_DIM)), MLA_KV_RANK),
        "mla_out_g": gain(ks[8], (L, MLA_WIDTH)),
        "w_o": nrm(ks[9], (L, MIX_WIDTH, D_MODEL), MIX_WIDTH),
        "norm_ffn_g": gain(ks[10], (L, D_MODEL)),
        "w_router": nrm(ks[11], (L, D_MODEL, N_EXPERTS), D_MODEL),
        "b_router": 0.01 * jax.random.normal(ks[12], (L, N_EXPERTS), f32),
        "w1": nrm(ks[13], (L, N_EXPERTS, D_MODEL, 2 * D_FF), D_MODEL),
        "b1": 0.01 * jax.random.normal(ks[14], (L, N_EXPERTS, 2 * D_FF), f32),
        "w2": nrm(ks[15], (L, N_EXPERTS, D_FF, D_MODEL), D_FF),
        "b2": 0.01 * jax.random.normal(ks[16], (L, N_EXPERTS, D_MODEL), f32),
        "norm_final_g": gain(ks[17], (D_MODEL,)),
    }


def reference(x, norm_attn_g, w_in, moba_out_g, q_a_norm_g, kv_a_norm_g, w_uq, w_ukv, mla_out_g,
              w_o, norm_ffn_g, w_router, b_router, w1, b1, w2, b2, norm_final_g):
    for l in range(DEPTH):
        h = rms_norm(x, norm_attn_g[l])
        x = x + token_mixer(h, w_in[l], moba_out_g[l], q_a_norm_g[l], kv_a_norm_g[l],
                            w_uq[l], w_ukv[l], mla_out_g[l], w_o[l])
        h = rms_norm(x, norm_ffn_g[l])
        x = x + moe_ffn(h, w_router[l], b_router[l], w1[l], b1[l], w2[l], b2[l])
    return rms_norm(x, norm_final_g)
```

```cpp
#include <hip/hip_runtime.h>
#include <cstdio>
#include <cstdint>

#ifndef MK_N_LAUNCHES
#define MK_N_LAUNCHES 1
#endif

constexpr int NBATCH = 2, SEQ = 8192, T = NBATCH * SEQ, DM = 2048;
constexpr int NPROJ = 4352;
constexpr int QFW = 1536, KVW = 2048;
constexpr int NE = 32, FF = 2048, TOPK = 4;
constexpr float NORM_EPS = 1e-5f;
constexpr int NPHASE = 12;

typedef unsigned short bf16_t;
typedef short bf16x8 __attribute__((ext_vector_type(8)));
typedef short s16x4 __attribute__((ext_vector_type(4)));
typedef float f32x4 __attribute__((ext_vector_type(4)));
typedef float f32x2 __attribute__((ext_vector_type(2)));
typedef float f32x16 __attribute__((ext_vector_type(16)));
typedef unsigned u32x4 __attribute__((ext_vector_type(4)));
typedef unsigned u32x2 __attribute__((ext_vector_type(2)));
#define LAS __attribute__((address_space(3)))
#define GAS __attribute__((address_space(1)))
#define RLX_AGENT __ATOMIC_RELAXED, __HIP_MEMORY_SCOPE_AGENT
#define LDS_WAIT() asm volatile("s_waitcnt lgkmcnt(0)" ::: "memory")
#define VM_WAIT() asm volatile("s_waitcnt vmcnt(0)" ::: "memory")
#define SBAR() __builtin_amdgcn_sched_barrier(0)

constexpr size_t MiB = 1u << 20;
constexpr size_t al(size_t x) { return (x + MiB - 1) / MiB * MiB; }
constexpr size_t WS_CTL = 0, CTL_ZERO_BYTES = 64 * 1024;
constexpr size_t WS_WIN = 1 * MiB;
constexpr size_t WS_WUQ = WS_WIN + al((size_t)NPROJ * DM * 2);
constexpr size_t WS_WUKV = WS_WUQ + al((size_t)QFW * 512 * 2);
constexpr size_t WS_WO = WS_WUKV + al((size_t)KVW * 512 * 2);
constexpr size_t WS_WR = WS_WO + al((size_t)DM * DM * 2);
constexpr size_t WS_W1 = WS_WR + al((size_t)NE * DM * 2);
constexpr size_t WS_W2 = WS_W1 + al((size_t)NE * 2 * FF * DM * 2);
constexpr size_t WS_ROPE = WS_W2 + al((size_t)NE * DM * FF * 2);
constexpr size_t WS_XN = WS_ROPE + al((size_t)SEQ * 64 * 4);
constexpr size_t WS_P = WS_XN + al((size_t)T * DM * 2);
constexpr size_t WS_CQN = WS_P + al((size_t)T * NPROJ * 2);
constexpr size_t WS_CKVN = WS_CQN + al((size_t)T * 512 * 2);
constexpr size_t WS_KR = WS_CKVN + al((size_t)T * 512 * 2);
constexpr size_t WS_KMEAN = WS_KR + al((size_t)T * 64 * 2);
constexpr size_t WS_QF = WS_KMEAN + al((size_t)512 * 128 * 4);
constexpr size_t WS_KV = WS_QF + al((size_t)T * QFW * 2);
constexpr size_t WS_LIST = WS_KV + al((size_t)T * KVW * 2);
constexpr size_t WS_PO = WS_LIST + al((size_t)512 * 8192 * 4);
constexpr size_t WS_LSE = WS_PO + al(((size_t)T * 32 + 1) * 128 * 2);
constexpr size_t WS_OCAT = WS_LSE + al(((size_t)T * 32 + 1) * 4);
constexpr size_t WS_X1 = WS_OCAT + al((size_t)T * DM * 2);
constexpr size_t WS_H2 = WS_X1 + al((size_t)T * DM * 4);
constexpr size_t WS_H2Q = WS_H2 + al((size_t)(T + 1) * DM * 2);
constexpr size_t WS_ELIST = WS_H2Q + al((size_t)(T + 1) * DM);
constexpr size_t WS_EGATE = WS_ELIST + al((size_t)NE * T * 4);
constexpr size_t WS_DEST = WS_EGATE + al((size_t)NE * T * 4);
constexpr size_t WS_ACT = WS_DEST + al((size_t)T * 4 * 4);
constexpr size_t WS_Y = WS_ACT + al((size_t)288 * 256 * FF * 2);
constexpr size_t WS_END = WS_Y + al((size_t)288 * 256 * DM * 2);
constexpr int CW_TMO = 0, CW_QUEUE = 64, CW_QUEUE2 = 320, CW_CQ = 448, CW_ECNT = 128, CW_MCNT = 1024, CW_BAR = 4096;

constexpr int RING_BYTES = 131072;
constexpr int MISC_OFF = RING_BYTES;
constexpr int TAB_OFF = RING_BYTES + 256;
constexpr int PRE_OFF = RING_BYTES + 4096;
constexpr int ROWSID_OFF = RING_BYTES + 8192;
constexpr int LDS_BYTES = RING_BYTES + 20480;

__device__ __forceinline__ unsigned cvt_pk_bf16(float lo, float hi) { unsigned r; asm volatile("v_cvt_pk_bf16_f32 %0, %1, %2" : "=v"(r) : "v"(lo), "v"(hi)); return r; }
typedef int i32x4 __attribute__((ext_vector_type(4)));
typedef int i32x8 __attribute__((ext_vector_type(8)));
__device__ __forceinline__ unsigned pk4_fp8(float a, float b, float c, float d) {
    a = __builtin_fminf(__builtin_fmaxf(a, -448.f), 448.f); b = __builtin_fminf(__builtin_fmaxf(b, -448.f), 448.f); c = __builtin_fminf(__builtin_fmaxf(c, -448.f), 448.f); d = __builtin_fminf(__builtin_fmaxf(d, -448.f), 448.f);
    int w = 0; w = __builtin_amdgcn_cvt_pk_fp8_f32(a, b, w, false); w = __builtin_amdgcn_cvt_pk_fp8_f32(c, d, w, true); return (unsigned)w;
}
__device__ __forceinline__ float bf2f(unsigned short b) { return __uint_as_float(((unsigned)b) << 16); }
__device__ __forceinline__ float bflo(unsigned w) { return __uint_as_float(w << 16); }
__device__ __forceinline__ float bfhi(unsigned w) { return __uint_as_float(w & 0xffff0000u); }
__device__ __forceinline__ float wave_sum(float v) {
#pragma unroll
    for (int o = 1; o < 64; o <<= 1) v += __shfl_xor(v, o);
    return v;
}

#define XB_TMO      128
#define XB_XCNT(j)  (256  + 64 * (j))
#define XB_XSUB(j)  (1280 + 64 * (j))
#define XB_XGEN(j)  (2304 + 64 * (j))
#define XB_TOP      3328
#define XB_TOPGEN   3392
#define XCD_BAR_WORDS 3456
#define XB_SPIN_CAP (1u << 22)
__device__ __forceinline__ unsigned xb_ld(unsigned* p)              { return __hip_atomic_load(p, __ATOMIC_RELAXED, __HIP_MEMORY_SCOPE_AGENT); }
__device__ __forceinline__ unsigned xb_add(unsigned* p, unsigned v) { return __hip_atomic_fetch_add(p, v, __ATOMIC_RELAXED, __HIP_MEMORY_SCOPE_AGENT); }
__device__ __forceinline__ unsigned xb_xcc_id() { return (unsigned)__builtin_amdgcn_s_getreg((3 << 11) | 20) & 0xFu; }
#define XB_SPIN(cond, bar) do { unsigned _sp = 0; while (cond) { __builtin_amdgcn_s_sleep(1); \
    if ((++_sp & 255u) == 0u) { if (xb_ld(&(bar)[XB_TMO])) break; if (_sp > XB_SPIN_CAP) { atomicAdd(&(bar)[XB_TMO], 1u); break; } } } } while (0)
struct XcdBarrier { unsigned* bar; unsigned x; volatile LAS unsigned* st; };
__device__ __forceinline__ XcdBarrier xcd_barrier_post(unsigned* bar, volatile LAS unsigned* st) {
    XcdBarrier b; b.bar = bar; b.x = xb_xcc_id(); b.st = st;
    if (threadIdx.x == 0) (void)xb_add(&bar[XB_XCNT(b.x)], 1u);
    return b;
}
__device__ __forceinline__ void xcd_barrier_complete(unsigned* bar, unsigned x, unsigned& nloc, unsigned& nx) {
    const unsigned G = gridDim.x * gridDim.y * gridDim.z;
    unsigned sum, cnt, mine, sp = 0u;
    for (;;) {
        sum = 0u; cnt = 0u; mine = 0u;
#pragma unroll
        for (unsigned j = 0; j < 16; ++j) { const unsigned c = xb_ld(&bar[XB_XCNT(j)]); sum += c; cnt += (c > 0u) ? 1u : 0u; mine = (j == x) ? c : mine; }
        if (sum == G) break;
        __builtin_amdgcn_s_sleep(1);
        if ((++sp & 255u) == 0u) { if (xb_ld(&bar[XB_TMO])) break; if (sp > XB_SPIN_CAP) { atomicAdd(&bar[XB_TMO], 1u); break; } }
    }
    nloc = mine > 0u ? mine : 1u; nx = cnt > 0u ? cnt : 1u;
}
__device__ __forceinline__ void xcd_barrier(const XcdBarrier& b) {
    asm volatile("s_waitcnt vmcnt(0)" ::: "memory");
    __syncthreads();
    if (threadIdx.x == 0) {
        unsigned* bar = b.bar;
        __builtin_amdgcn_s_waitcnt(0);
        unsigned nloc = b.st[0], nx = b.st[1];
        if (nloc == 0u) { xcd_barrier_complete(bar, b.x, nloc, nx); b.st[0] = nloc; b.st[1] = nx; }
        const unsigned old = xb_add(&bar[XB_XSUB(b.x)], 1u);
        const unsigned gen = old / nloc;
        if (old + 1u == (gen + 1u) * nloc) {
            __builtin_amdgcn_fence(__ATOMIC_RELEASE, "agent");
            asm volatile("s_waitcnt vmcnt(0)" ::: "memory");
            const unsigned og = xb_add(&bar[XB_TOP], 1u);
            const unsigned tg = og / nx;
            if (og + 1u == (tg + 1u) * nx) xb_add(&bar[XB_TOPGEN], 1u);
            else XB_SPIN(xb_ld(&bar[XB_TOPGEN]) == tg, bar);
            __builtin_amdgcn_fence(__ATOMIC_ACQUIRE, "agent");
            xb_add(&bar[XB_XGEN(b.x)], 1u);
            asm volatile("s_waitcnt vmcnt(0)" ::: "memory");
        } else {
            XB_SPIN(xb_ld(&bar[XB_XGEN(b.x)]) == gen, bar);
            __builtin_amdgcn_fence(__ATOMIC_ACQUIRE, "agent");
            asm volatile("s_waitcnt vmcnt(0)" ::: "memory");
        }
    }
    __syncthreads();
}

namespace pg8 {
constexpr int BM = 256, BK = 64, HALF = 128, HTB = HALF * BK * 2, STAGE_BYTES = 8 * HTB, NXCD = 8, WGM = 4;
__host__ __device__ __forceinline__ int lds_byte(int r, int c) { const int st = (r >> 4) * 2 + (c >> 5), rr = r & 15, cc = c & 31, ob = rr * 64 + cc * 2; return st * 1024 + (ob ^ (((ob >> 9) & 1) << 5)); }
__host__ __device__ __forceinline__ void stage_rc(int b, int& R, int& C) { const int st = b / 1024, sb = b % 1024, swz = sb ^ (((sb >> 9) & 1) << 5); R = (st >> 1) * 16 + swz / 64; C = (st & 1) * 32 + (swz % 64) / 2; }
__host__ __device__ __forceinline__ int perm32(int rho) { const int n = rho >> 4, i = rho & 15; return 8 * (i >> 2) + 4 * n + (i & 3); }

struct Unit { int pm, pn, e, r0; };
struct Gemm { const bf16_t* A; const bf16_t* Bt; int M, N, K; };

__device__ __forceinline__ bool order_next(int i, int G, int c, int nM, int nN, int& pm, int& pn) {
    const int nwg = nM * nN; const long L = (long)i * G + c; if (L >= nwg) return false;
    int wgid = (int)L; { const int q = nwg / NXCD, r = nwg % NXCD, xcd = wgid % NXCD, off = wgid / NXCD; wgid = (xcd < r ? xcd * (q + 1) : r * (q + 1) + (xcd - r) * q) + off; }
    const int nig = WGM * nN, gid = wgid / nig, fm = gid * WGM, gsz = (nM - fm) < WGM ? (nM - fm) : WGM;
    pm = fm + ((wgid % nig) % gsz); pn = (wgid % nig) / gsz; return true;
}
struct StaticOrder {
    int nM, nN, G, c;
    __device__ void init(int M, int N, int G_, int c_) { nM = M / BM; nN = N / BM; G = G_; c = c_; }
    __device__ __forceinline__ bool next(int i, Unit& u) const { u.e = 0; u.r0 = 0; return order_next(i, G, c, nM, nN, u.pm, u.pn); }
    __device__ __forceinline__ const char* b_ptr(const Gemm& g, const Unit& u) const { return (const char*)g.Bt + (size_t)u.pn * (size_t)BM * g.K * 2; }
    __device__ __forceinline__ unsigned row_off(const Unit&, int, int) const { return 0u; }
};
struct MoeOrder {
    int nM, nN, G, c; const LAS int* tile_e; const LAS int* tile_r0; const LAS int* ecnt; const int* elist; size_t estride;
    __device__ __forceinline__ bool next(int i, Unit& u) const { if (!order_next(i, G, c, nM, nN, u.pm, u.pn)) return false; u.e = __builtin_amdgcn_readfirstlane(tile_e[u.pm]); u.r0 = __builtin_amdgcn_readfirstlane(tile_r0[u.pm]); return true; }
    __device__ __forceinline__ const char* b_ptr(const Gemm& g, const Unit& u) const { return (const char*)g.Bt + ((size_t)u.e * estride + (size_t)u.pn * (size_t)BM * g.K) * 2; }
    __device__ __forceinline__ unsigned row_off(const Unit& u, int vrow, int K) const {
        const int idx = u.r0 + vrow; int tok = T; if (idx < ecnt[u.e]) tok = elist[(size_t)u.e * T + idx];
        return (unsigned)tok * (unsigned)(K * 2);
    }
};

template <class Epi, class Sched, bool GATHER, bool FP8 = false>
__device__ __forceinline__ void gemm_phase(LAS unsigned char* lds, const Gemm g, const Sched& S, const Epi& E) {
    const int tid = threadIdx.x, wid = __builtin_amdgcn_readfirstlane(tid >> 6), lane = tid & 63, wr = wid >> 2, wc = wid & 3, fr = lane & 15, fq = lane >> 4;
    const int K = g.K, nt = K / BK;
    unsigned voffA[2], voffB[2]; int RA[2];
#pragma unroll
    for (int i = 0; i < 2; ++i) { int R, C; stage_rc(tid * 16 + i * 8192, R, C); const int Rb = Epi::PERM ? ((R & ~31) + perm32(R & 31)) : R;
        RA[i] = R; voffA[i] = GATHER ? (unsigned)(C * 2) : (unsigned)(R * K + C) * 2u; voffB[i] = (unsigned)(Rb * K + C) * 2u; }
    const size_t kstep = (size_t)(BK * 2);
    const size_t hstep = (size_t)HALF * K * 2;
    const size_t tstep = 2 * hstep;
    const unsigned ldsw = (unsigned)wid * 1024u;
    const int aoff = lds_byte(wr * 64 + fr, fq * 8), boff = lds_byte(wc * 32 + fr, fq * 8);
    unsigned gc[2][2] = {{0u, 0u}, {0u, 0u}}, gn[2][2] = {{0u, 0u}, {0u, 0u}};
#define PG8_SA(b, h) (((b) * 2 + (h)) * HTB)
#define PG8_SB(b, h) ((4 + (b) * 2 + (h)) * HTB)
#define PG8_STAGE(bufoff, gbase, voff) do { _Pragma("unroll") for (int _i = 0; _i < 2; ++_i) \
        __builtin_amdgcn_global_load_lds((const unsigned*)((const char*)(gbase) + (voff)[_i]), (LAS unsigned*)(lds + (bufoff) + ldsw + _i * 8192), 16, 0, 0); } while (0)
#define PG8_STAGE_A(bufoff, gbase, h, NX) do { if constexpr (GATHER) { _Pragma("unroll") for (int _i = 0; _i < 2; ++_i) \
        __builtin_amdgcn_global_load_lds((const unsigned*)((const char*)(gbase) + ((NX) ? gn[h][_i] : gc[h][_i]) + voffA[_i]), (LAS unsigned*)(lds + (bufoff) + ldsw + _i * 8192), 16, 0, 0); } \
        else { PG8_STAGE(bufoff, (const char*)(gbase) + (h) * hstep, voffA); } } while (0)
#define PG8_LD8(base) __builtin_shufflevector(*(const LAS i32x4*)(base), *(const LAS i32x4*)((base) + 1024), 0, 1, 2, 3, 4, 5, 6, 7)
#define PG8_LDA(dst, b, h) do { if constexpr (FP8) { _Pragma("unroll") for (int m = 0; m < 4; ++m) dst##8[m] = PG8_LD8(lds + PG8_SA(b, h) + aoff + m * 2048); } \
        else { _Pragma("unroll") for (int m = 0; m < 4; ++m) _Pragma("unroll") for (int k = 0; k < 2; ++k) dst[m][k] = *(const LAS bf16x8*)(lds + PG8_SA(b, h) + aoff + m * 2048 + k * 1024); } } while (0)
#define PG8_LDB(dst, b, h) do { if constexpr (FP8) { _Pragma("unroll") for (int n = 0; n < 2; ++n) dst##8[n] = PG8_LD8(lds + PG8_SB(b, h) + boff + n * 2048); } \
        else { _Pragma("unroll") for (int n = 0; n < 2; ++n) _Pragma("unroll") for (int k = 0; k < 2; ++k) dst[n][k] = *(const LAS bf16x8*)(lds + PG8_SB(b, h) + boff + n * 2048 + k * 1024); } } while (0)
#define PG8_MMA(ai, bj, At, Bt) do { __builtin_amdgcn_s_setprio(1); _Pragma("unroll") for (int m = 0; m < 4; ++m) _Pragma("unroll") for (int n = 0; n < 2; ++n) { \
        if constexpr (FP8) { asm volatile("v_mfma_scale_f32_16x16x128_f8f6f4 %0, %1, %2, %0, %3, %3 op_sel_hi:[0,0,0]" : "+v"(acc[ai][bj][m][n]) : "v"(Bt##8[n]), "v"(At##8[m]), "v"(sc7f)); } \
        else { _Pragma("unroll") for (int k = 0; k < 2; ++k) acc[ai][bj][m][n] = __builtin_amdgcn_mfma_f32_16x16x32_bf16(Bt[n][k], At[m][k], acc[ai][bj][m][n], 0, 0, 0); } } \
        __builtin_amdgcn_s_setprio(0); } while (0)
#define PG8_WAIT_V(n) asm volatile("s_waitcnt vmcnt(" #n ")" ::: "memory")
#define PG8_WAIT_L(n) asm volatile("s_waitcnt lgkmcnt(" #n ")" ::: "memory")
#define PG8_BAR __builtin_amdgcn_s_barrier()
#define PG8_SCHED __builtin_amdgcn_sched_barrier(0)
#define PG8_GLOAD(dst, u) do { if constexpr (GATHER) { _Pragma("unroll") for (int _h = 0; _h < 2; ++_h) _Pragma("unroll") for (int _i = 0; _i < 2; ++_i) dst[_h][_i] = S.row_off(u, _h * HALF + RA[_i], K); } } while (0)
    Unit cur, nxt; int ui = 0;
    if (!S.next(0, cur)) return;
    f32x4 acc[2][2][4][2];
#pragma unroll
    for (int a = 0; a < 2; ++a)
#pragma unroll
        for (int b = 0; b < 2; ++b)
#pragma unroll
            for (int m = 0; m < 4; ++m)
#pragma unroll
                for (int n = 0; n < 2; ++n) acc[a][b][m][n] = (f32x4){0.f, 0.f, 0.f, 0.f};
    bf16x8 At[4][2], B0[2][2], B1[2][2]; i32x8 At8[4], B08[2], B18[2];
    int sc7f = 0x7f7f7f7f; asm volatile("" : "+v"(sc7f));
    const char* cA = GATHER ? (const char*)g.A : (const char*)g.A + (size_t)cur.pm * tstep; const char* cB = S.b_ptr(g, cur);
    PG8_GLOAD(gc, cur);
    if constexpr (GATHER) { PG8_WAIT_V(0); }
    PG8_STAGE(PG8_SB(0, 0), cB, voffB); PG8_STAGE(PG8_SB(0, 1), cB + hstep, voffB); PG8_STAGE_A(PG8_SA(0, 0), cA, 0, false); PG8_STAGE_A(PG8_SA(0, 1), cA, 1, false);
    if (wr == 1) PG8_BAR;
    PG8_WAIT_V(2); PG8_BAR;
    PG8_STAGE(PG8_SB(1, 0), cB + kstep, voffB); PG8_STAGE_A(PG8_SA(1, 0), cA + kstep, 0, false); PG8_STAGE(PG8_SB(1, 1), cB + hstep + kstep, voffB);
    PG8_WAIT_V(6); PG8_BAR;
    for (;;) {
        const bool has_next = S.next(ui + 1, nxt);
        const char* nA = has_next ? (GATHER ? (const char*)g.A : (const char*)g.A + (size_t)nxt.pm * tstep) : cA; const char* nB = has_next ? S.b_ptr(g, nxt) : cB;
        if constexpr (GATHER) { if (has_next) { PG8_GLOAD(gn, nxt); } else { gn[0][0] = gc[0][0]; gn[0][1] = gc[0][1]; gn[1][0] = gc[1][0]; gn[1][1] = gc[1][1]; } }
        if constexpr (Epi::PREF) E.prefetch(cur, ui);
        for (int t = 0; t < nt; t += 2) {
            const bool last = (t == nt - 2);
            const char* a1 = cA + (size_t)(t + 1) * kstep;
            const char* a2 = last ? nA : cA + (size_t)(t + 2) * kstep; const char* b2 = last ? nB : cB + (size_t)(t + 2) * kstep;
            const char* a3 = a2 + kstep; const char* b3 = b2 + kstep;
            PG8_LDB(B0, 0, 0); PG8_LDB(B1, 0, 1); PG8_SCHED; PG8_LDA(At, 0, 0); PG8_STAGE_A(PG8_SA(1, 1), a1, 1, false);
            PG8_WAIT_V(8); PG8_WAIT_L(0); PG8_BAR; PG8_MMA(0, 0, At, B0); PG8_MMA(0, 1, At, B1); PG8_BAR; PG8_SCHED;
            PG8_LDA(At, 0, 1); PG8_STAGE(PG8_SB(0, 0), b2, voffB); PG8_STAGE(PG8_SB(0, 1), b2 + hstep, voffB); PG8_STAGE_A(PG8_SA(0, 0), a2, 0, last);
            PG8_WAIT_V(8); PG8_WAIT_L(0); PG8_BAR; PG8_MMA(1, 0, At, B0); PG8_MMA(1, 1, At, B1); PG8_BAR; PG8_SCHED;
            PG8_LDB(B0, 1, 0); PG8_LDB(B1, 1, 1); PG8_SCHED; PG8_LDA(At, 1, 0); PG8_STAGE_A(PG8_SA(0, 1), a2, 1, last);
            PG8_WAIT_V(8); PG8_WAIT_L(0); PG8_BAR; PG8_MMA(0, 0, At, B0); PG8_MMA(0, 1, At, B1); PG8_BAR; PG8_SCHED;
            PG8_LDA(At, 1, 1); PG8_STAGE(PG8_SB(1, 0), b3, voffB); PG8_STAGE(PG8_SB(1, 1), b3 + hstep, voffB); PG8_STAGE_A(PG8_SA(1, 0), a3, 0, last);
            PG8_WAIT_V(8); PG8_WAIT_L(0); PG8_BAR; PG8_MMA(1, 0, At, B0); PG8_MMA(1, 1, At, B1); PG8_BAR; PG8_SCHED;
        }
        if constexpr (FP8) asm volatile("s_nop 15\n\ts_nop 15" ::: "memory");
        if (wr == 0) PG8_BAR;
        { int fr_ = fr, fq_ = fq; if constexpr (FP8) asm volatile("" : "+v"(fr_), "+v"(fq_));
          E(acc, cur, wr, wc, fr_, fq_, ui); }
        if (!has_next) break;
#pragma unroll
        for (int a = 0; a < 2; ++a)
#pragma unroll
            for (int b = 0; b < 2; ++b)
#pragma unroll
                for (int m = 0; m < 4; ++m)
#pragma unroll
                    for (int n = 0; n < 2; ++n) acc[a][b][m][n] = (f32x4){0.f, 0.f, 0.f, 0.f};
        cur = nxt; cA = nA; cB = nB; ++ui;
        if constexpr (GATHER) { gc[0][0] = gn[0][0]; gc[0][1] = gn[0][1]; gc[1][0] = gn[1][0]; gc[1][1] = gn[1][1]; }
        if (wr == 1) PG8_BAR;
    }
    PG8_WAIT_V(0);
    PG8_BAR;
#undef PG8_SA
#undef PG8_SB
#undef PG8_STAGE
#undef PG8_STAGE_A
#undef PG8_LDA
#undef PG8_LD8
#undef PG8_LDB
#undef PG8_MMA
#undef PG8_WAIT_V
#undef PG8_WAIT_L
#undef PG8_BAR
#undef PG8_SCHED
#undef PG8_GLOAD
}

struct EpiBf16 {
    static constexpr bool PERM = true; static constexpr bool PREF = false;
    bf16_t* O; int ldc;
    __device__ __forceinline__ void operator()(const f32x4 (&acc)[2][2][4][2], const Unit& u, int wr, int wc, int fr, int fq, int ui) const {
        const int row0 = u.pm * BM + wr * 64 + fr, col0 = u.pn * BM + wc * 32 + 8 * fq;
#pragma unroll
        for (int ai = 0; ai < 2; ++ai)
#pragma unroll
            for (int m = 0; m < 4; ++m) { bf16_t* rowp = O + (size_t)(row0 + ai * HALF + m * 16) * ldc + col0;
#pragma unroll
                for (int bj = 0; bj < 2; ++bj) { const f32x4 v0 = acc[ai][bj][m][0], v1 = acc[ai][bj][m][1];
                    u32x4 w; w.x = cvt_pk_bf16(v0[0], v0[1]); w.y = cvt_pk_bf16(v0[2], v0[3]); w.z = cvt_pk_bf16(v1[0], v1[1]); w.w = cvt_pk_bf16(v1[2], v1[3]);
                    *(u32x4*)(rowp + bj * HALF) = w; } }
    }
};
struct EpiQRope {
    static constexpr bool PERM = true; static constexpr bool PREF = false;
    bf16_t* O; const float* ropetab;
    __device__ __forceinline__ void operator()(const f32x4 (&acc)[2][2][4][2], const Unit& u, int wr, int wc, int fr, int fq, int ui) const {
        const int row0 = u.pm * BM + wr * 64 + fr, col0 = u.pn * BM + wc * 32 + 8 * fq;
#pragma unroll
        for (int bj = 0; bj < 2; ++bj) { const int col = col0 + bj * HALF, hc = col % 192; const bool rope = hc >= 128; const int i0 = rope ? (hc - 128) >> 1 : 0;
#pragma unroll
            for (int ai = 0; ai < 2; ++ai)
#pragma unroll
                for (int m = 0; m < 4; ++m) { const int row = row0 + ai * HALF + m * 16, pos = row & (SEQ - 1);
                    f32x4 v0 = acc[ai][bj][m][0], v1 = acc[ai][bj][m][1];
                    const f32x4 cs = *(const f32x4*)(ropetab + (size_t)pos * 32 + i0), sn = *(const f32x4*)(ropetab + (size_t)SEQ * 32 + (size_t)pos * 32 + i0);
                    if (rope) { f32x4 a, b;
                        a[0] = v0[0] * cs[0] - v0[1] * sn[0]; a[1] = v0[1] * cs[0] + v0[0] * sn[0]; a[2] = v0[2] * cs[1] - v0[3] * sn[1]; a[3] = v0[3] * cs[1] + v0[2] * sn[1];
                        b[0] = v1[0] * cs[2] - v1[1] * sn[2]; b[1] = v1[1] * cs[2] + v1[0] * sn[2]; b[2] = v1[2] * cs[3] - v1[3] * sn[3]; b[3] = v1[3] * cs[3] + v1[2] * sn[3];
                        v0 = a; v1 = b; }
                    u32x4 w; w.x = cvt_pk_bf16(v0[0], v0[1]); w.y = cvt_pk_bf16(v0[2], v0[3]); w.z = cvt_pk_bf16(v1[0], v1[1]); w.w = cvt_pk_bf16(v1[2], v1[3]);
                    *(u32x4*)(O + (size_t)row * QFW + col) = w;
                    asm volatile("" ::: "memory"); } }
    }
};
struct EpiResBf16 {
    static constexpr bool PERM = true; static constexpr bool PREF = false;
    const float* base; bf16_t* C;
    __device__ __forceinline__ void operator()(const f32x4 (&acc)[2][2][4][2], const Unit& u, int wr, int wc, int fr, int fq, int ui) const {
        const int row0 = u.pm * BM + wr * 64 + fr, col0 = u.pn * BM + wc * 32 + 8 * fq;
#pragma unroll
        for (int ai = 0; ai < 2; ++ai)
#pragma unroll
            for (int m = 0; m < 4; ++m) { const size_t off = (size_t)(row0 + ai * HALF + m * 16) * DM + col0;
#pragma unroll
                for (int bj = 0; bj < 2; ++bj) { const f32x4 v0 = *(const f32x4*)(base + off + bj * HALF) + acc[ai][bj][m][0], v1 = *(const f32x4*)(base + off + bj * HALF + 4) + acc[ai][bj][m][1];
                    u32x4 w; w.x = cvt_pk_bf16(v0[0], v0[1]); w.y = cvt_pk_bf16(v0[2], v0[3]); w.z = cvt_pk_bf16(v1[0], v1[1]); w.w = cvt_pk_bf16(v1[2], v1[3]);
                    *(u32x4*)(C + off + bj * HALF) = w; }
                asm volatile("" ::: "memory"); }
    }
};
struct EpiSwiglu {
    static constexpr bool PERM = true; static constexpr bool PREF = true;
    unsigned char* O; const float* b1; LAS float* pf;
    __device__ __forceinline__ void prefetch(const Unit& u, int ui) const {
        const int t = threadIdx.x, w = __builtin_amdgcn_readfirstlane(t >> 6);
        const float* src = b1 + (size_t)u.e * (2 * FF) + u.pn * HALF + (t & 127) + ((t & 128) ? FF : 0);
        __builtin_amdgcn_global_load_lds((const unsigned*)src, (LAS unsigned*)(pf + (ui & 1) * 512 + w * 64), 4, 0, 0);
    }
    __device__ __forceinline__ void operator()(const f32x4 (&acc)[2][2][4][2], const Unit& u, int wr, int wc, int fr, int fq, int ui) const {
        const int row0 = u.pm * BM + wr * 64 + fr, cl = u.pn * HALF + wc * 32 + 8 * fq;
        const LAS float* bp = pf + (ui & 1) * 512 + wc * 32 + 8 * fq;
        const f32x4 bg0 = *(const LAS f32x4*)bp, bg1 = *(const LAS f32x4*)(bp + 4), bl0 = *(const LAS f32x4*)(bp + 128), bl1 = *(const LAS f32x4*)(bp + 132);
        constexpr float DS = 1.0f / 16384.0f;
#pragma unroll
        for (int ai = 0; ai < 2; ++ai)
#pragma unroll
            for (int mh = 0; mh < 2; ++mh) { u32x2 wp[2];
#pragma unroll
                for (int mm = 0; mm < 2; ++mm) { const int m = 2 * mh + mm;
                    f32x4 r[2];
#pragma unroll
                    for (int n = 0; n < 2; ++n) { const f32x4 gv = acc[ai][0][m][n] * DS + (n ? bg1 : bg0), lv = acc[ai][1][m][n] * DS + (n ? bl1 : bl0);
#pragma unroll
                        for (int h = 0; h < 2; ++h) {
                            f32x2 g2 = {fminf(gv[2 * h], 7.0f), fminf(gv[2 * h + 1], 7.0f)}, l2 = {fminf(fmaxf(lv[2 * h], -7.0f), 7.0f), fminf(fmaxf(lv[2 * h + 1], -7.0f), 7.0f)};
                            const f32x2 t2 = g2 * (f32x2){-1.702f * 1.4426950408889634f, -1.702f * 1.4426950408889634f};
                            const f32x2 d2 = (f32x2){__builtin_amdgcn_exp2f(t2.x), __builtin_amdgcn_exp2f(t2.y)} + (f32x2){1.0f, 1.0f};
                            const f32x2 q2 = g2 * (f32x2){__builtin_amdgcn_rcpf(d2.x), __builtin_amdgcn_rcpf(d2.y)};
                            const f32x2 r2 = q2 * (l2 * (f32x2){4.0f, 4.0f} + (f32x2){4.0f, 4.0f});
                            r[n][2 * h] = r2.x; r[n][2 * h + 1] = r2.y; } }
                    int w0 = 0, w1 = 0;
                    w0 = __builtin_amdgcn_cvt_pk_fp8_f32(r[0][0], r[0][1], w0, false); w0 = __builtin_amdgcn_cvt_pk_fp8_f32(r[0][2], r[0][3], w0, true);
                    w1 = __builtin_amdgcn_cvt_pk_fp8_f32(r[1][0], r[1][1], w1, false); w1 = __builtin_amdgcn_cvt_pk_fp8_f32(r[1][2], r[1][3], w1, true);
                    wp[mm].x = (unsigned)w0; wp[mm].y = (unsigned)w1; }
                const auto sx = __builtin_amdgcn_permlane16_swap(wp[0].x, wp[1].x, false, false), sy = __builtin_amdgcn_permlane16_swap(wp[0].y, wp[1].y, false, false);
                const u32x4 v = {sx[0], sy[0], sx[1], sy[1]};
                *(u32x4*)(O + (size_t)(row0 + ai * HALF + (2 * mh + (fq & 1)) * 16) * FF + u.pn * HALF + wc * 32 + 16 * (fq >> 1)) = v; }
    }
};
struct EpiDown {
    static constexpr bool PERM = true; static constexpr bool PREF = true;
    unsigned char* O; const float* b2; const float* egate; const LAS int* ecnt; LAS float* pf;
    __device__ __forceinline__ void prefetch(const Unit& u, int ui) const {
        const int t = threadIdx.x, w = __builtin_amdgcn_readfirstlane(t >> 6);
        const float* src = (t < 256) ? b2 + (size_t)u.e * DM + u.pn * BM + t : egate + (size_t)u.e * T + u.r0 + (t - 256);
        __builtin_amdgcn_global_load_lds((const unsigned*)src, (LAS unsigned*)(pf + (ui & 1) * 512 + w * 64), 4, 0, 0);
    }
    __device__ __forceinline__ void operator()(const f32x4 (&acc)[2][2][4][2], const Unit& u, int wr, int wc, int fr, int fq, int ui) const {
        const int rl0 = wr * 64 + fr, col0 = u.pn * BM + wc * 32 + 8 * fq; const int cnt = ecnt[u.e];
        const LAS float* pb = pf + (ui & 1) * 512; const LAS float* bp = pb + wc * 32 + 8 * fq;
        f32x4 bv[2][2];
#pragma unroll
        for (int bj = 0; bj < 2; ++bj)
#pragma unroll
            for (int n = 0; n < 2; ++n) bv[bj][n] = *(const LAS f32x4*)(bp + bj * HALF + 4 * n);
#pragma unroll
        for (int ai = 0; ai < 2; ++ai)
#pragma unroll
            for (int mh = 0; mh < 2; ++mh) { u32x2 wq[2][2];
#pragma unroll
                for (int mm = 0; mm < 2; ++mm) { const int m = 2 * mh + mm, rl = rl0 + ai * HALF + m * 16, idx = u.r0 + rl; float gt = 0.f; if (idx < cnt) gt = 64.f * pb[256 + rl];
#pragma unroll
                    for (int bj = 0; bj < 2; ++bj) { const f32x4 v0 = (acc[ai][bj][m][0] * (1.0f / 4096.0f) + bv[bj][0]) * gt, v1 = (acc[ai][bj][m][1] * (1.0f / 4096.0f) + bv[bj][1]) * gt;
                        wq[mm][bj].x = pk4_fp8(v0[0], v0[1], v0[2], v0[3]); wq[mm][bj].y = pk4_fp8(v1[0], v1[1], v1[2], v1[3]); } }
                unsigned char* rowp = O + (size_t)(u.pm * BM + rl0 + ai * HALF + (2 * mh + (fq & 1)) * 16) * DM + u.pn * BM + wc * 32 + 16 * (fq >> 1);
#pragma unroll
                for (int bj = 0; bj < 2; ++bj) { const auto sx = __builtin_amdgcn_permlane16_swap(wq[0][bj].x, wq[1][bj].x, false, false), sy = __builtin_amdgcn_permlane16_swap(wq[0][bj].y, wq[1][bj].y, false, false);
                    const u32x4 v = {sx[0], sy[0], sx[1], sy[1]};
                    *(u32x4*)(rowp + bj * HALF) = v; } }
    }
};
}

namespace att {
constexpr int SHM_V = 64 * 128 * 2;
constexpr float THR = 8.f;
__device__ __forceinline__ int v_st(int k, int c) { const int kk = (k & ~0xC) | ((k & 4) << 1) | ((k & 8) >> 1); return ((kk >> 3) * 4 + (c >> 5)) * 512 + ((kk & 7) * 32 + (c & 31)) * 2; }
__device__ __forceinline__ int v_rd_base(int lane) { return ((lane & 3) << 3) | (((lane >> 2) & 3) << 6) | (((lane >> 4) & 1) << 5) | (((lane >> 5) & 1) << 8); }
constexpr int v_rd_off(int d0, int ks, int half) { return d0 * 512 + ks * 4096 + half * 2048; }
__device__ __forceinline__ int crow(int r, int hi) { return (r & 3) + 8 * (r >> 2) + 4 * hi; }
__device__ __forceinline__ unsigned cvtpk(float lo, float hi) { unsigned r; asm volatile("v_cvt_pk_bf16_f32 %0, %1, %2" : "=v"(r) : "v"(lo), "v"(hi)); return r; }
__device__ __forceinline__ void mask_tile(f32x16& p0, f32x16& p1, int dq) {
    const float NEG = -__builtin_inff();
#pragma unroll
    for (int r = 0; r < 16; ++r) {
        const int c = (r & 3) + 8 * (r >> 2);
        if (dq - c < 0) p0[r] = NEG;
        if (dq - c - 32 < 0) p1[r] = NEG;
    }
}
template <int DQK> __device__ __forceinline__ void partialSM(f32x16& p0, f32x16& p1, float& m_reg, float& mn, float& alpha) {
    constexpr float SCALE = DQK == 192 ? 0.07216878364870322f : 0.08838834764831845f;
    float pmax = p0[0];
#pragma unroll
    for (int r = 1; r < 16; ++r) pmax = fmaxf(pmax, p0[r]);
#pragma unroll
    for (int r = 0; r < 16; ++r) pmax = fmaxf(pmax, p1[r]);
    { auto rr = __builtin_amdgcn_permlane32_swap(__float_as_uint(pmax), __float_as_uint(pmax), false, false);
      pmax = fmaxf(__uint_as_float(rr[0]), __uint_as_float(rr[1])); }
    constexpr float C2 = 1.4426950408889634f * SCALE;
    const bool need = (pmax - m_reg) * SCALE > THR;
    mn = need ? fmaxf(m_reg, pmax) : m_reg; alpha = need ? __builtin_amdgcn_exp2f((m_reg - mn) * C2) : 1.f; m_reg = mn;
    const float mnL = -mn * C2;
#pragma unroll
    for (int r = 0; r < 16; ++r) p0[r] = fmaf(p0[r], C2, mnL);
#pragma unroll
    for (int r = 0; r < 16; ++r) p1[r] = fmaf(p1[r], C2, mnL);
#pragma unroll
    for (int r = 0; r < 16; ++r) p0[r] = __builtin_amdgcn_exp2f(p0[r]);
}
__device__ __forceinline__ void finishSM(f32x16& p0, f32x16& p1, float alpha, float& l_reg, bf16x8& pa0, bf16x8& pa1, bf16x8& pa2, bf16x8& pa3) {
#pragma unroll
    for (int r = 0; r < 16; ++r) p1[r] = __builtin_amdgcn_exp2f(p1[r]);
    float ps = 0;
#pragma unroll
    for (int r = 0; r < 16; ++r) ps += p0[r];
#pragma unroll
    for (int r = 0; r < 16; ++r) ps += p1[r];
    { auto rr = __builtin_amdgcn_permlane32_swap(__float_as_uint(ps), __float_as_uint(ps), false, false);
      ps = __uint_as_float(rr[0]) + __uint_as_float(rr[1]); }
    l_reg = l_reg * alpha + ps;
#define PK4(P, B_, OUT) do { unsigned a0 = cvtpk(P[B_+0], P[B_+1]), a1 = cvtpk(P[B_+2], P[B_+3]);                          \
        unsigned b0 = cvtpk(P[B_+4], P[B_+5]), b1 = cvtpk(P[B_+6], P[B_+7]);                                             \
        auto r0 = __builtin_amdgcn_permlane32_swap(a0, b0, false, false); auto r1 = __builtin_amdgcn_permlane32_swap(a1, b1, false, false); \
        u32x4 w = {r0[0], r1[0], r0[1], r1[1]}; OUT = *reinterpret_cast<bf16x8*>(&w); } while (0)
    PK4(p0, 0, pa0); PK4(p0, 8, pa1); PK4(p1, 0, pa2); PK4(p1, 8, pa3);
#undef PK4
}
template <int DQK, int KB>
__device__ __forceinline__ void qkt(f32x16& p0, f32x16& p1, const char* K_lds, int r32, int hi, const bf16x8* qr) {
    constexpr int ROWB = DQK * 2, SHM_K = 64 * ROWB;
    p0 = f32x16{}; p1 = f32x16{};
    const char* kb[4];
#pragma unroll
    for (int dd = 0; dd < 4; ++dd) kb[dd] = K_lds + KB * SHM_K + r32 * ROWB + (((dd * 16 + hi * 8) * 2) ^ ((r32 & 7) << 4));
#pragma unroll
    for (int d0 = 0; d0 < DQK / 16; ++d0) { const char* a = kb[d0 & 3] + (d0 >> 2) * 128;
        bf16x8 b0 = *reinterpret_cast<const bf16x8*>(a);
        bf16x8 b1 = *reinterpret_cast<const bf16x8*>(a + 32 * ROWB);
        p0 = __builtin_amdgcn_mfma_f32_32x32x16_bf16(b0, qr[d0], p0, 0, 0, 0);
        p1 = __builtin_amdgcn_mfma_f32_32x32x16_bf16(b1, qr[d0], p1, 0, 0, 0); }
}
template <int VB>
__device__ __forceinline__ void pv_tile(f32x16* o, int vb0, bf16x8 pa0, bf16x8 pa1, bf16x8 pa2, bf16x8 pa3) {
#define TRRD(dst, off) asm volatile("ds_read_b64_tr_b16 %0, %1 offset:%2" : "=&v"(dst) : "v"(vb0), "i"(off) : "memory")
#define PV_D0(d0) do { s16x4 l0, l1, l2, l3, h0, h1, h2, h3; constexpr int b_ = VB * SHM_V + v_rd_off(d0, 0, 0); \
        TRRD(l0, b_); TRRD(h0, b_ + 2048); TRRD(l1, b_ + 4096); TRRD(h1, b_ + 6144); TRRD(l2, b_ + 8192); TRRD(h2, b_ + 10240); TRRD(l3, b_ + 12288); TRRD(h3, b_ + 14336); \
        asm volatile("s_waitcnt lgkmcnt(0)" ::: "memory"); SBAR();   \
        o[d0] = __builtin_amdgcn_mfma_f32_32x32x16_bf16(pa0, (bf16x8){l0[0], l0[1], l0[2], l0[3], h0[0], h0[1], h0[2], h0[3]}, o[d0], 0, 0, 0);   \
        o[d0] = __builtin_amdgcn_mfma_f32_32x32x16_bf16(pa1, (bf16x8){l1[0], l1[1], l1[2], l1[3], h1[0], h1[1], h1[2], h1[3]}, o[d0], 0, 0, 0);   \
        o[d0] = __builtin_amdgcn_mfma_f32_32x32x16_bf16(pa2, (bf16x8){l2[0], l2[1], l2[2], l2[3], h2[0], h2[1], h2[2], h2[3]}, o[d0], 0, 0, 0);   \
        o[d0] = __builtin_amdgcn_mfma_f32_32x32x16_bf16(pa3, (bf16x8){l3[0], l3[1], l3[2], l3[3], h3[0], h3[1], h3[2], h3[3]}, o[d0], 0, 0, 0); } while (0)
    PV_D0(0); PV_D0(1); PV_D0(2); PV_D0(3);
#undef PV_D0
#undef TRRD
}

constexpr int NRING = 3;
template <int DQK, bool BIAS>
__device__ __forceinline__ void attn_unit(char* lds, const bf16x8* qr, const bf16_t* Kn, int kpitch, const bf16_t* Kr, const bf16_t* Vp, int vpitch,
                                          int kb0, int NT, int qpos, int qlo, bool causal, float biasraw, f32x16* o, float& m_reg, float& l_reg) {
    constexpr int ROWB = DQK * 2, SHM_K = 64 * ROWB;
    const int tid = threadIdx.x, wid = __builtin_amdgcn_readfirstlane(tid >> 6), lane = tid & 63, r32 = lane & 31, hi = lane >> 5;
    char* V_lds = lds; char* K_lds = lds + NRING * SHM_V;
    float* ws = (float*)(lds + NRING * SHM_V + NRING * SHM_K) + wid * 64; float* al_l = ws + 32;
    const int sr = tid >> 4, sc = (tid & 15) * 8, vst0 = v_st(sr, sc), vst1 = v_st(32 + sr, sc), kws = sr * ROWB + ((sc * 2) ^ ((sr & 7) << 4));
    const int rr_ = tid >> 3, rc = (tid & 7) * 8, kws2 = rr_ * ROWB + 256 + ((rc * 2) ^ ((rr_ & 7) << 4));
    const int vb0 = (int)(uintptr_t)V_lds + v_rd_base(lane);
    const unsigned goff = (unsigned)(sr * (int)kpitch + sc) * 2u, goff2 = (unsigned)(rr_ * 64 + rc) * 2u;
    bf16x8 st_k0, st_k1, st_k2 = {}, st_v0, st_v1;
#define A_SLOAD(kb) do { const char* kt_ = (const char*)Kn + (size_t)(kb) * kpitch * 2; const char* vt_ = (const char*)Vp + (size_t)(kb) * vpitch * 2; \
        st_v0 = *(const bf16x8*)(vt_ + goff); st_v1 = *(const bf16x8*)(vt_ + (size_t)32 * vpitch * 2 + goff); \
        st_k0 = *(const bf16x8*)(kt_ + goff); st_k1 = *(const bf16x8*)(kt_ + (size_t)32 * kpitch * 2 + goff); \
        if constexpr (DQK == 192) st_k2 = *(const bf16x8*)((const char*)Kr + (size_t)(kb) * 128 + goff2); } while (0)
#define A_SWRITE(bf) do { *(bf16x8*)(K_lds + (bf) * SHM_K + kws) = st_k0; *(bf16x8*)(K_lds + (bf) * SHM_K + kws + 32 * ROWB) = st_k1; \
        if constexpr (DQK == 192) *(bf16x8*)(K_lds + (bf) * SHM_K + kws2) = st_k2; \
        *(bf16x8*)(V_lds + (bf) * SHM_V + vst0) = st_v0; *(bf16x8*)(V_lds + (bf) * SHM_V + vst1) = st_v1; } while (0)
#define A_RESC(a) do { if (__any((a) < 1.f)) { if (hi == 0) al_l[r32] = (a); asm volatile("s_waitcnt lgkmcnt(0)" ::: "memory");              \
        _Pragma("unroll") for (int d_ = 0; d_ < 4; ++d_) _Pragma("unroll") for (int r = 0; r < 16; ++r) o[d_][r] *= al_l[crow(r, hi)]; } } while (0)
#define A_BAR() do { asm volatile("s_waitcnt lgkmcnt(0)" ::: "memory"); __builtin_amdgcn_s_barrier(); asm volatile("" ::: "memory"); } while (0)
    m_reg = -1e30f; l_reg = 0.f;
#pragma unroll
    for (int d = 0; d < 4; ++d) o[d] = f32x16{};
    A_SLOAD(kb0); VM_WAIT(); A_SWRITE(0);
    if (NT > 1) { A_SLOAD(kb0 + 64); VM_WAIT(); A_SWRITE(1); }
    __syncthreads();
    if (wid >= 4) A_BAR();
#define A_STEP(t, BUF) do { const int kb = kb0 + (t) * 64;                                                            \
        if ((t) + 2 < NT) A_SLOAD(kb + 128);                                                                          \
        f32x16 p0, p1; SBAR(); qkt<DQK, BUF>(p0, p1, K_lds, r32, hi, qr);                                             \
        if constexpr (BIAS) { const float bl = biasraw * (float)((t) * 64 + 4 * hi);                                  \
            _Pragma("unroll") for (int r = 0; r < 16; ++r) { const float bc = fmaf(biasraw, (float)((r & 3) + 8 * (r >> 2)), bl); p0[r] += bc; p1[r] += bc + 32.f * biasraw; } } \
        if (causal && kb + 63 > qlo) mask_tile(p0, p1, qpos - kb - 4 * hi);                                           \
        A_BAR();                                                                                                      \
        float mn, alpha; partialSM<DQK>(p0, p1, m_reg, mn, alpha);                                                    \
        A_RESC(alpha);                                                                                                \
        bf16x8 pa0, pa1, pa2, pa3; finishSM(p0, p1, alpha, l_reg, pa0, pa1, pa2, pa3); SBAR();                        \
        pv_tile<BUF>(o, vb0, pa0, pa1, pa2, pa3);                                                                     \
        if ((t) + 2 < NT) { A_SWRITE(((BUF) + 2) % NRING); }                                                          \
        A_BAR(); } while (0)
    int t = 0;
    for (; t + 2 < NT; t += 3) { A_STEP(t, 0); A_STEP(t + 1, 1); A_STEP(t + 2, 2); }
    if (t < NT) { A_STEP(t, 0); if (t + 1 < NT) A_STEP(t + 1, 1); }
    if (wid < 4) A_BAR();
#undef A_STEP
#undef A_BAR
#undef A_RESC
#undef A_SWRITE
#undef A_SLOAD
}
}

constexpr int NWAVES = 8;
struct Args { const float* in[18]; float* out; unsigned char* ws; int ph_lo, ph_hi; };
struct Frame {
    LAS unsigned char* lds; char* ldsg;
    volatile LAS unsigned* MISC;
    unsigned* ctl;
    int tid, lane, wave, G, gw, NGW;
};
#define IN_F(i) (A.in[i])
#define WSP(T_, off) ((T_*)(A.ws + (off)))

template <int MODE> __device__ __forceinline__ int drow(int n) {
    if (MODE == 1) { const int h = n / 192, nl = n - h * 192; return nl < 128 ? n : h * 192 + 128 + ((nl - 128) & 31) * 2 + ((nl - 128) >> 5); }
    if (MODE == 2) { return n < FF ? ((n >> 7) * 256 + (n & 127)) : (((n - FF) >> 7) * 256 + 128 + ((n - FF) & 127)); }
    return n;
}
template <int MODE> __device__ __forceinline__ void p0_transpose_item(const float* W, int K, int N, bf16_t* WT, LAS float* scr, int item, int lane, const float* kscale = nullptr) {
    const int nblk = N / 32, kb = item / nblk, nb = item % nblk, k0 = 64 * kb, n0 = 32 * nb;
#pragma unroll 8
    for (int i = 0; i < 32; ++i) { const int kk = 2 * i + (lane >> 5); float v = W[(size_t)(k0 + kk) * N + n0 + (lane & 31)]; if (kscale) v *= kscale[k0 + kk]; scr[kk * 33 + (lane & 31)] = v; }
    LDS_WAIT(); asm volatile("" ::: "memory");
    const int c = lane & 7;
#pragma unroll
    for (int j = 0; j < 4; ++j) { const int n = (lane >> 3) + 8 * j; const LAS float* s = scr + (8 * c) * 33 + n;
        u32x4 o; o.x = cvt_pk_bf16(s[0 * 33], s[1 * 33]); o.y = cvt_pk_bf16(s[2 * 33], s[3 * 33]); o.z = cvt_pk_bf16(s[4 * 33], s[5 * 33]); o.w = cvt_pk_bf16(s[6 * 33], s[7 * 33]);
        *(u32x4*)(WT + (size_t)drow<MODE>(n0 + n) * K + k0 + 8 * c) = o; }
    LDS_WAIT(); asm volatile("" ::: "memory");
}
__device__ __forceinline__ void cv_load(const float* W, int N, int nblk, int item, int lane, f32x4 (&tv)[16]) {
    const int kb = item / nblk, nb = item - kb * nblk; const float* p = W + (size_t)(64 * kb + 16 * (lane >> 4)) * N + 64 * nb + 4 * (lane & 15);
#pragma unroll
    for (int i = 0; i < 16; ++i) tv[i] = __builtin_nontemporal_load((const f32x4*)(p + (size_t)i * N));
}
template <int MODE> __device__ __forceinline__ void cv_finish(const f32x4 (&tv)[16], int K, int nblk, unsigned char* WT, int item, int lane) {
    const int kb = item / nblk, nb = item - kb * nblk, k0 = 64 * kb + 16 * (lane >> 4), n0 = 64 * nb + 4 * (lane & 15);
    unsigned D[16];
#pragma unroll
    for (int i = 0; i < 16; ++i) { const f32x2 a = (f32x2){tv[i].x, tv[i].y} * (f32x2){1024.f, 1024.f}, b = (f32x2){tv[i].z, tv[i].w} * (f32x2){1024.f, 1024.f};
        D[i] = pk4_fp8(a.x, a.y, b.x, b.y); }
    unsigned O[4][4];
#pragma unroll
    for (int q = 0; q < 4; ++q) { const unsigned a = D[4 * q], b = D[4 * q + 1], c = D[4 * q + 2], d = D[4 * q + 3];
        const unsigned t0 = __builtin_amdgcn_perm(b, a, 0x05010400u), t1 = __builtin_amdgcn_perm(b, a, 0x07030602u), u0 = __builtin_amdgcn_perm(d, c, 0x05010400u), u1 = __builtin_amdgcn_perm(d, c, 0x07030602u);
        O[0][q] = __builtin_amdgcn_perm(u0, t0, 0x05040100u); O[1][q] = __builtin_amdgcn_perm(u0, t0, 0x07060302u); O[2][q] = __builtin_amdgcn_perm(u1, t1, 0x05040100u); O[3][q] = __builtin_amdgcn_perm(u1, t1, 0x07060302u); }
#pragma unroll
    for (int j = 0; j < 4; ++j) { u32x4 o; o.x = O[j][0]; o.y = O[j][1]; o.z = O[j][2]; o.w = O[j][3];
        __builtin_nontemporal_store(o, (u32x4*)(WT + (size_t)drow<MODE>(n0 + j) * K + k0)); }
}
template <int MODE> __device__ __forceinline__ void cv_run4(const float* W, int K, int N, unsigned char* WT, int item0, int lane) {
    const int nblk = N / 64; f32x4 ta[16];
#pragma unroll 1
    for (int j = 0; j < 4; ++j) { cv_load(W, N, nblk, item0 + j, lane, ta); cv_finish<MODE>(ta, K, nblk, WT, item0 + j, lane); }
}
template <bool Q8> __device__ __forceinline__ void rms_row_to_bf16(const float* xrow, const float* g, bf16_t* orow, unsigned char* qrow, int lane) {
    const f32x4* xr = (const f32x4*)xrow + lane; const f32x4* gr = (const f32x4*)g + lane;
    f32x4 v[8]; float s = 0.f;
#pragma unroll
    for (int j = 0; j < 8; ++j) { v[j] = xr[64 * j]; s += (v[j].x * v[j].x + v[j].y * v[j].y) + (v[j].z * v[j].z + v[j].w * v[j].w); }
    const float rstd = 1.f / sqrtf(wave_sum(s) * (1.f / DM) + NORM_EPS);
    u32x2* o8 = (u32x2*)orow + lane; unsigned* q4 = (unsigned*)qrow + lane;
#pragma unroll
    for (int j = 0; j < 8; ++j) { const f32x4 gg = gr[64 * j]; const float a = v[j].x * rstd * gg.x, b = v[j].y * rstd * gg.y, c = v[j].z * rstd * gg.z, d = v[j].w * rstd * gg.w;
        u32x2 w; w.x = cvt_pk_bf16(a, b); w.y = cvt_pk_bf16(c, d); o8[64 * j] = w;
        if constexpr (Q8) q4[64 * j] = pk4_fp8(a * 16.f, b * 16.f, c * 16.f, d * 16.f); }
}
__device__ __forceinline__ void p0_prologue(Frame& F, const Args& A) {
    LAS float* scr = (LAS float*)(F.lds + F.wave * 16384);
    constexpr int I_IN = 32 * 130, I_UQ = 8 * 48, I_UKV = 8 * 64, I_O = 32 * 64, I_R = 32;
    constexpr int I_SMALL = I_IN + I_UQ + I_UKV + I_O + I_R;
    for (int it = F.gw; it < I_SMALL; it += F.NGW) {
        int r = it;
        if (r < I_IN) { p0_transpose_item<0>(IN_F(2), DM, 4160, WSP(bf16_t, WS_WIN), scr, r, F.lane); continue; } r -= I_IN;
        if (r < I_UQ) { p0_transpose_item<1>(IN_F(6), 512, QFW, WSP(bf16_t, WS_WUQ), scr, r, F.lane); continue; } r -= I_UQ;
        if (r < I_UKV) { p0_transpose_item<0>(IN_F(7), 512, KVW, WSP(bf16_t, WS_WUKV), scr, r, F.lane); continue; } r -= I_UKV;
        if (r < I_O) { p0_transpose_item<0>(IN_F(9), DM, DM, WSP(bf16_t, WS_WO), scr, r, F.lane); continue; } r -= I_O;
        p0_transpose_item<0>(IN_F(11), DM, NE, WSP(bf16_t, WS_WR), scr, r, F.lane, IN_F(10));
    }
    for (int i = F.gw * 64 + F.lane; i < SEQ * 32; i += F.NGW * 64) { const int t = i >> 5, f = i & 31;
        const double inv = exp(-(double)(2 * f) / 64.0 * 9.210340371976184); double s, c; sincos((double)t * inv, &s, &c);
        WSP(float, WS_ROPE)[i] = (float)c; WSP(float, WS_ROPE)[SEQ * 32 + i] = (float)s; }
    for (int m = F.gw; m < T; m += F.NGW) rms_row_to_bf16<false>(IN_F(0) + (size_t)m * DM, IN_F(1), WSP(bf16_t, WS_XN) + (size_t)m * DM, nullptr, F.lane);
}

__device__ __forceinline__ void p2_thin(Frame& F, const Args& A) {
    const int lane = F.lane;
    for (int m = F.gw; m < T; m += F.NGW) {
        const bf16_t* prow = WSP(bf16_t, WS_P) + (size_t)m * NPROJ;
#pragma unroll
        for (int w = 0; w < 2; ++w) {
            const u32x4 v = *(const u32x4*)(prow + 3072 + w * 512 + lane * 8);
            float f[8] = {bflo(v.x), bfhi(v.x), bflo(v.y), bfhi(v.y), bflo(v.z), bfhi(v.z), bflo(v.w), bfhi(v.w)};
            float s = 0.f;
#pragma unroll
            for (int j = 0; j < 8; ++j) s += f[j] * f[j];
            const float rstd = 1.f / sqrtf(wave_sum(s) * (1.f / 512.f) + NORM_EPS);
            const float* g = (w ? IN_F(5) : IN_F(4)) + lane * 8; const f32x4 g0 = *(const f32x4*)g, g1 = *(const f32x4*)(g + 4);
            u32x4 o; o.x = cvt_pk_bf16(f[0] * rstd * g0.x, f[1] * rstd * g0.y); o.y = cvt_pk_bf16(f[2] * rstd * g0.z, f[3] * rstd * g0.w);
            o.z = cvt_pk_bf16(f[4] * rstd * g1.x, f[5] * rstd * g1.y); o.w = cvt_pk_bf16(f[6] * rstd * g1.z, f[7] * rstd * g1.w);
            *(u32x4*)((w ? WSP(bf16_t, WS_CKVN) : WSP(bf16_t, WS_CQN)) + (size_t)m * 512 + lane * 8) = o;
        }
    }
    for (int grp = blockIdx.x; grp < T / 64; grp += F.G) {
        const int r32 = lane & 31, hi = lane >> 5, wave = F.wave; LAS float* part = (LAS float*)F.lds;
        __syncthreads();
        { const bf16_t* ap = WSP(bf16_t, WS_WIN) + (size_t)(4096 + r32) * DM + wave * 256 + hi * 8;
          const bf16_t* bp = WSP(bf16_t, WS_XN) + (size_t)(grp * 64 + r32) * DM + wave * 256 + hi * 8;
          f32x16 c00 = {}, c01 = {}, c10 = {}, c11 = {};
#pragma unroll 4
          for (int ks = 0; ks < 16; ++ks) { const bf16x8 a0 = *(const bf16x8*)(ap + ks * 16), a1 = *(const bf16x8*)(ap + (size_t)32 * DM + ks * 16);
              const bf16x8 b0 = *(const bf16x8*)(bp + ks * 16), b1 = *(const bf16x8*)(bp + (size_t)32 * DM + ks * 16);
              c00 = __builtin_amdgcn_mfma_f32_32x32x16_bf16(a0, b0, c00, 0, 0, 0); c01 = __builtin_amdgcn_mfma_f32_32x32x16_bf16(a1, b0, c01, 0, 0, 0);
              c10 = __builtin_amdgcn_mfma_f32_32x32x16_bf16(a0, b1, c10, 0, 0, 0); c11 = __builtin_amdgcn_mfma_f32_32x32x16_bf16(a1, b1, c11, 0, 0, 0); }
#pragma unroll
          for (int r = 0; r < 16; ++r) { part[((wave * 4 + 0) * 16 + r) * 64 + lane] = c00[r]; part[((wave * 4 + 1) * 16 + r) * 64 + lane] = c01[r];
                                         part[((wave * 4 + 2) * 16 + r) * 64 + lane] = c10[r]; part[((wave * 4 + 3) * 16 + r) * 64 + lane] = c11[r]; } }
        __syncthreads();
        if (wave < 2) { f32x16 xa = {}, xb = {};
#pragma unroll 1
            for (int w8 = 0; w8 < 8; ++w8)
#pragma unroll
                for (int r = 0; r < 16; ++r) { xa[r] += part[((w8 * 4 + wave * 2 + 0) * 16 + r) * 64 + lane]; xb[r] += part[((w8 * 4 + wave * 2 + 1) * 16 + r) * 64 + lane]; }
            const int m = grp * 64 + wave * 32 + r32, pos = m & (SEQ - 1); bf16_t* kr = WSP(bf16_t, WS_KR) + (size_t)m * 64;
#pragma unroll
            for (int r = 0; r < 16; ++r) { const int i = att::crow(r, hi); const float c = WSP(float, WS_ROPE)[pos * 32 + i], sn = WSP(float, WS_ROPE)[SEQ * 32 + pos * 32 + i];
                *(unsigned*)(kr + 2 * i) = cvt_pk_bf16(xa[r] * c - xb[r] * sn, xb[r] * c + xa[r] * sn); } }
    }
    __syncthreads();
    for (int it = F.gw; it < 512; it += F.NGW) {
        const int bh = it >> 5, blk = it & 31, b = bh >> 3, h = bh & 7;
        const bf16_t* base = WSP(bf16_t, WS_P) + (size_t)(b * SEQ + blk * 256 + (lane >> 4)) * NPROJ + 1024 + h * 128 + (lane & 15) * 8;
        float a[8] = {0.f, 0.f, 0.f, 0.f, 0.f, 0.f, 0.f, 0.f};
#pragma unroll 8
        for (int r = 0; r < 64; ++r) { const u32x4 v = *(const u32x4*)(base + (size_t)(4 * r) * NPROJ);
            a[0] += bflo(v.x); a[1] += bfhi(v.x); a[2] += bflo(v.y); a[3] += bfhi(v.y); a[4] += bflo(v.z); a[5] += bfhi(v.z); a[6] += bflo(v.w); a[7] += bfhi(v.w); }
#pragma unroll
        for (int j = 0; j < 8; ++j) { a[j] += __shfl_xor(a[j], 16); a[j] += __shfl_xor(a[j], 32); a[j] *= (1.f / 256.f); }
        if (lane < 16) { float* o = WSP(float, WS_KMEAN) + (size_t)it * 128 + lane * 8; *(f32x4*)o = (f32x4){a[0], a[1], a[2], a[3]}; *(f32x4*)(o + 4) = (f32x4){a[4], a[5], a[6], a[7]}; }
    }
}

__device__ __forceinline__ void p3_gating(Frame& F, const Args& A) {
    constexpr int KMP = 132;
    LAS float* km = (LAS float*)F.lds;
    const int lane = F.lane, r32 = lane & 31, hi = lane >> 5;
    for (int item = blockIdx.x; item < 256; item += F.G) {
        const int bh = item >> 4, chunk = item & 15, b = bh >> 3, h = bh & 7;
        __syncthreads();
        for (int i = F.tid; i < 32 * 32; i += 512) *(LAS f32x4*)(km + (i >> 5) * KMP + (i & 31) * 4) = ((const f32x4*)(WSP(float, WS_KMEAN) + (size_t)bh * 32 * 128))[i];
        __syncthreads();
        const int pos0 = chunk * 512 + F.wave * 64, cur = __builtin_amdgcn_readfirstlane(pos0 >> 8);
        bf16x8 ah[8], al[8];
#pragma unroll
        for (int ks = 0; ks < 8; ++ks) { const LAS float* kp = km + r32 * KMP + ks * 16 + hi * 8; const f32x4 k0 = *(const LAS f32x4*)kp, k1 = *(const LAS f32x4*)(kp + 4);
            u32x4 wh; wh.x = cvt_pk_bf16(k0.x, k0.y); wh.y = cvt_pk_bf16(k0.z, k0.w); wh.z = cvt_pk_bf16(k1.x, k1.y); wh.w = cvt_pk_bf16(k1.z, k1.w);
            u32x4 wl; wl.x = cvt_pk_bf16(k0.x - bflo(wh.x), k0.y - bfhi(wh.x)); wl.y = cvt_pk_bf16(k0.z - bflo(wh.y), k0.w - bfhi(wh.y));
            wl.z = cvt_pk_bf16(k1.x - bflo(wh.z), k1.y - bfhi(wh.z)); wl.w = cvt_pk_bf16(k1.z - bflo(wh.w), k1.w - bfhi(wh.w));
            ah[ks] = __builtin_bit_cast(bf16x8, wh); al[ks] = __builtin_bit_cast(bf16x8, wl); }
        const float NEG = -__builtin_inff();
        int selg[2][3];
#pragma unroll
        for (int g2 = 0; g2 < 2; ++g2) {
            const bf16_t* qp = WSP(bf16_t, WS_P) + (size_t)(b * SEQ + pos0 + g2 * 32 + r32) * NPROJ + h * 128 + hi * 8;
            f32x16 acc = {};
#pragma unroll
            for (int ks = 0; ks < 8; ++ks) { const bf16x8 qf = *(const bf16x8*)(qp + ks * 16);
                acc = __builtin_amdgcn_mfma_f32_32x32x16_bf16(ah[ks], qf, acc, 0, 0, 0); acc = __builtin_amdgcn_mfma_f32_32x32x16_bf16(al[ks], qf, acc, 0, 0, 0); }
            float v[16];
#pragma unroll
            for (int r = 0; r < 16; ++r) v[r] = (att::crow(r, hi) < cur) ? acc[r] : NEG;
            float cv[6]; int ci[6];
#pragma unroll
            for (int k = 0; k < 3; ++k) { float bv = NEG; int bi = 0;
#pragma unroll
                for (int r = 0; r < 16; ++r) if (v[r] > bv) { bv = v[r]; bi = r; }
#pragma unroll
                for (int r = 0; r < 16; ++r) if (r == bi) v[r] = NEG;
                cv[k] = bv; ci[k] = att::crow(bi, hi); }
#pragma unroll
            for (int k = 0; k < 3; ++k) { cv[3 + k] = __shfl_xor(cv[k], 32); ci[3 + k] = __shfl_xor(ci[k], 32); }
#pragma unroll
            for (int k = 0; k < 3; ++k) { float bv = NEG; int bc = 0, be = 1 << 30;
#pragma unroll
                for (int c = 0; c < 6; ++c) if (cv[c] > bv || (cv[c] == bv && cv[c] > NEG && ci[c] < be)) { bv = cv[c]; bc = c; be = ci[c]; }
#pragma unroll
                for (int c = 0; c < 6; ++c) if (c == bc) cv[c] = NEG;
                selg[g2][k] = (bv > NEG) ? be : -1; }
        }
        const int pos = pos0 + lane;
        int sel[3] = {hi ? selg[1][0] : selg[0][0], hi ? selg[1][1] : selg[0][1], hi ? selg[1][2] : selg[0][2]};
        int mycnt = 0;
        for (int n = 0; n < cur; ++n) { const bool p = (sel[0] == n) || (sel[1] == n) || (sel[2] == n); const unsigned long long mk = __ballot(p); if (lane == n) mycnt = __popcll(mk); }
        unsigned* mc = F.ctl + CW_MCNT + bh * 32;
        int mybase = 0; if (mycnt > 0) mybase = (int)__hip_atomic_fetch_add(mc + lane, (unsigned)mycnt, RLX_AGENT);
        for (int n = 0; n < cur; ++n) { const bool p = (sel[0] == n) || (sel[1] == n) || (sel[2] == n); const unsigned long long mk = __ballot(p);
            const int bs = __shfl(mybase, n);
            if (p) { const int rank = __popcll(mk & ((1ull << lane) - 1ull)); const int sl = (sel[0] == n) ? 0 : ((sel[1] == n) ? 1 : 2);
                WSP(int, WS_LIST)[(size_t)(bh * 32 + n) * 8192 + bs + rank] = pos | (sl << 13); } }
    }
}

constexpr int CV_I_W1E = 32 * 64, CV_I_W2E = 32 * 32, CV_NITEMS = NE * CV_I_W1E + NE * CV_I_W2E, CV_NGRP = CV_NITEMS / 4;
__device__ __forceinline__ void conv_wave(Frame& F, const Args& A, volatile LAS unsigned* done = nullptr) {
    for (;;) {
        if (done) { if (__builtin_amdgcn_readfirstlane((int)*done) >= 4) break; }
        unsigned u = 0u; if (F.lane == 0) u = __hip_atomic_fetch_add(F.ctl + CW_CQ, 1u, RLX_AGENT);
        const int c = __builtin_amdgcn_readfirstlane((int)u);
        if (c >= CV_NGRP) break;
        const int r0 = c * 4;
        if (r0 < NE * CV_I_W1E) { const int e = r0 / CV_I_W1E;
            cv_run4<2>(IN_F(13) + (size_t)e * DM * 2 * FF, DM, 2 * FF, WSP(unsigned char, WS_W1) + (size_t)e * 2 * FF * DM, r0 - e * CV_I_W1E, F.lane); }
        else { const int r = r0 - NE * CV_I_W1E, e = r / CV_I_W2E;
            cv_run4<0>(IN_F(15) + (size_t)e * FF * DM, FF, DM, WSP(unsigned char, WS_W2) + (size_t)e * DM * FF, r - e * CV_I_W2E, F.lane); }
    }
}

constexpr int PO_DUMP = T * 32;
__device__ __forceinline__ void p4_setup(Frame& F) {
    LAS int* cntl = (LAS int*)(F.lds + PRE_OFF + 2048);
    cntl[F.tid] = (int)__hip_atomic_load(F.ctl + CW_MCNT + F.tid, RLX_AGENT);
    __syncthreads();
}
__device__ __forceinline__ void p4_mla_loop(Frame& F, const Args& A, const int qo) {
    const int tid = F.tid, lane = F.lane, wid = F.wave;
    char* lds = F.ldsg;
    for (;;) {
        __syncthreads();
        if (tid == 0) F.MISC[16] = __hip_atomic_fetch_add(F.ctl + CW_QUEUE + qo, 1u, RLX_AGENT);
        __syncthreads();
        const int it = __builtin_amdgcn_readfirstlane((int)F.MISC[16]);
        if (it >= 512) break;
        int ln = lane; asm volatile("" : "+v"(ln)); const int r32 = ln & 31, hi = ln >> 5;
        const int qb = 31 - (it >> 4), bh = it & 15, b = bh >> 3, h = bh & 7;
        const int m0 = b * SEQ + qb * 256 + wid * 32;
        bf16x8 qr[12];
        { const bf16_t* qp = WSP(bf16_t, WS_QF) + (size_t)(m0 + r32) * QFW + h * 192 + hi * 8;
#pragma unroll
          for (int d0 = 0; d0 < 12; ++d0) qr[d0] = *(const bf16x8*)(qp + d0 * 16); }
        f32x16 o[4]; float m_reg, l_reg;
        att::attn_unit<192, false>(lds, qr, WSP(bf16_t, WS_KV) + (size_t)b * SEQ * KVW + h * 256, KVW, WSP(bf16_t, WS_KR) + (size_t)b * SEQ * 64, WSP(bf16_t, WS_KV) + (size_t)b * SEQ * KVW + h * 256 + 128, KVW,
                                   0, (qb + 1) * 4, qb * 256 + wid * 32 + r32, qb * 256 + wid * 32, true, 0.f, o, m_reg, l_reg);
        float* ws = (float*)(lds + att::NRING * att::SHM_V + att::NRING * 64 * 384) + wid * 64;
        if (hi == 0) ws[r32] = l_reg; LDS_WAIT();
        const char* Ow = (const char*)(WSP(bf16_t, WS_OCAT) + (size_t)(b * SEQ + qb * 256 + wid * 32) * DM + 1024 + h * 128);
        const unsigned loff = (unsigned)((4 * hi) * DM + r32) * 2u;
#pragma unroll
        for (int r = 0; r < 16; ++r) { const int orow = att::crow(r, hi); const float rl = __builtin_amdgcn_rcpf(ws[orow]);
            const char* rb = Ow + (size_t)((r & 3) + 8 * (r >> 2)) * DM * 2;
#pragma unroll
            for (int d0 = 0; d0 < 4; ++d0) { const float v = o[d0][r] * rl; const float vn = __shfl_xor(v, 1);
                if ((r32 & 1) == 0) *(unsigned*)(rb + loff + d0 * 64) = cvt_pk_bf16(v, vn); } }
    }
}
__device__ __forceinline__ void p4_moba_loop(Frame& F, const Args& A, const int qo, const bool cvmode) {
    const int tid = F.tid, lane = F.lane, wid = F.wave;
    LAS int* cntl = (LAS int*)(F.lds + PRE_OFF + 2048); LAS int* rowsid = (LAS int*)(F.lds + ROWSID_OFF);
    char* lds = F.ldsg;
    for (;;) {
        __syncthreads();
        if (tid == 0) { F.MISC[17] = __hip_atomic_fetch_add(F.ctl + CW_QUEUE2 + qo, 1u, RLX_AGENT); F.MISC[20] = 0u; }
        __syncthreads();
        const int it = __builtin_amdgcn_readfirstlane((int)F.MISC[17]);
        if (it >= 512) break;
        int ln = lane; asm volatile("" : "+v"(ln)); const int r32 = ln & 31, hi = ln >> 5;
        const int n = it >> 4, bh = it & 15, b = bh >> 3, h = bh & 7, L = bh * 32 + n;
        const int cnt = __builtin_amdgcn_readfirstlane(cntl[L]);
        char* V_lds = lds + 65536; char* K_lds = lds;
        const bf16_t* kvb = WSP(bf16_t, WS_P) + (size_t)(b * SEQ + n * 256) * NPROJ + h * 128;
        {
            int t2 = tid; asm volatile("" : "+v"(t2));
            const int sr = t2 >> 4, sc = (t2 & 15) * 8, vst0 = att::v_st(sr, sc), vst1 = att::v_st(32 + sr, sc), kws = sr * 256 + ((sc * 2) ^ ((sr & 7) << 4));
            const unsigned goff = (unsigned)(sr * NPROJ + sc) * 2u;
#pragma unroll
            for (int j = 0; j < 4; ++j) { const char* kt = (const char*)(kvb + 1024) + (size_t)(j * 64) * NPROJ * 2; const char* vt = (const char*)(kvb + 2048) + (size_t)(j * 64) * NPROJ * 2;
                const bf16x8 k0 = *(const bf16x8*)(kt + goff), k1 = *(const bf16x8*)(kt + (size_t)32 * NPROJ * 2 + goff), v0 = *(const bf16x8*)(vt + goff), v1 = *(const bf16x8*)(vt + (size_t)32 * NPROJ * 2 + goff);
                *(bf16x8*)(K_lds + j * 16384 + kws) = k0; *(bf16x8*)(K_lds + j * 16384 + kws + 32 * 256) = k1;
                *(bf16x8*)(V_lds + j * 16384 + vst0) = v0; *(bf16x8*)(V_lds + j * 16384 + vst1) = v1; }
        }
        __syncthreads();
        const float slope = __builtin_amdgcn_exp2f(-(float)(h + 1));
        const float biasraw = slope * 11.313708498984761f;
        float* ws = (float*)(lds + RING_BYTES + 10240) + wid * 64; float* al_l = ws + 32; LAS int* rs = rowsid + wid * 32;
        const int vb0 = (int)(uintptr_t)V_lds + att::v_rd_base(ln);
        const int ntask = 8 + ((cnt + 31) >> 5);
        const int wstride = cvmode ? 4 : 8;
        if (cvmode && wid >= 4) { conv_wave(F, A, F.MISC + 20); continue; }
        for (int tk = wid; tk < ntask; tk += wstride) {
            const bool own = tk < 8; int pos, sid;
            if (own) { pos = n * 256 + tk * 32 + r32; sid = ((b * SEQ + pos) * 8 + h) * 4 + 3; }
            else { const int idx = (tk - 8) * 32 + r32; pos = 0; sid = PO_DUMP;
                   if (idx < cnt) { const int ent = WSP(int, WS_LIST)[(size_t)L * 8192 + idx]; pos = ent & 8191; sid = ((b * SEQ + pos) * 8 + h) * 4 + (ent >> 13); } }
            if (hi == 0) rs[r32] = sid;
            bf16x8 qr[8];
            { const bf16_t* qp = WSP(bf16_t, WS_P) + (size_t)(b * SEQ + pos) * NPROJ + h * 128 + hi * 8;
#pragma unroll
              for (int d0 = 0; d0 < 8; ++d0) qr[d0] = *(const bf16x8*)(qp + d0 * 16); }
            const int ntile = own ? (tk >> 1) + 1 : 4;
            const int qrel = pos - n * 256;
            f32x16 o[4]; float m_reg = -1e30f, l_reg = 0.f;
#pragma unroll
            for (int d = 0; d < 4; ++d) o[d] = f32x16{};
#define MB_STEP(J) do { if ((J) < ntile) { f32x16 p0, p1; SBAR(); att::qkt<128, J>(p0, p1, K_lds, r32, hi, qr);                     \
                { float br_ = biasraw; asm volatile("" : "+v"(br_)); const float bl = br_ * (float)((J) * 64 + 4 * hi);     \
                  _Pragma("unroll") for (int r = 0; r < 16; ++r) { const float bc = fmaf(br_, (float)((r & 3) + 8 * (r >> 2)), bl); p0[r] += bc; p1[r] += bc + 32.f * br_; } } \
                if (own && (J) * 64 + 63 > tk * 32) att::mask_tile(p0, p1, qrel - (J) * 64 - 4 * hi);                               \
                float mn, alpha; att::partialSM<128>(p0, p1, m_reg, mn, alpha);                                                     \
                if (__any(alpha < 1.f)) { if (hi == 0) al_l[r32] = alpha; asm volatile("s_waitcnt lgkmcnt(0)" ::: "memory");       \
                    _Pragma("unroll") for (int d_ = 0; d_ < 4; ++d_) _Pragma("unroll") for (int r = 0; r < 16; ++r) o[d_][r] *= al_l[att::crow(r, hi)]; } \
                bf16x8 pa0, pa1, pa2, pa3; att::finishSM(p0, p1, alpha, l_reg, pa0, pa1, pa2, pa3); SBAR();                         \
                att::pv_tile<J>(o, vb0, pa0, pa1, pa2, pa3); } } while (0)
            MB_STEP(0); MB_STEP(1); MB_STEP(2); MB_STEP(3);
#undef MB_STEP
            if (hi == 0) { ws[r32] = l_reg;
                WSP(float, WS_LSE)[sid] = m_reg * (1.4426950408889634f * 0.08838834764831845f) + __builtin_amdgcn_logf(l_reg) + slope * 1.4426950408889634f * (float)(n * 256 - pos); }
            LDS_WAIT();
            char* bb0 = lds + RING_BYTES + 12288 + wid * 512; char* bb1 = lds + RING_BYTES + 16384 + wid * 512;
#pragma unroll
            for (int r = 0; r < 16; ++r) { const int orow = att::crow(r, hi); const float rl = __builtin_amdgcn_rcpf(ws[orow]); const int os = rs[orow];
                char* bb = (r & 1) ? bb1 : bb0;
#pragma unroll
                for (int d0 = 0; d0 < 4; ++d0) { const float v = o[d0][r] * rl; const float vn = __shfl_xor(v, 1);
                    if ((r32 & 1) == 0) *(unsigned*)(bb + hi * 256 + d0 * 64 + r32 * 2) = cvt_pk_bf16(v, vn); }
                asm volatile("" ::: "memory");
                const u32x2 w = *(const u32x2*)(bb + hi * 256 + r32 * 8);
                asm volatile("" ::: "memory");
                *(u32x2*)((char*)(WSP(bf16_t, WS_PO) + (size_t)os * 128) + r32 * 8) = w; }
            LDS_WAIT();
        }
        if (cvmode && lane == 0) __hip_atomic_fetch_add((LAS unsigned*)(F.lds + MISC_OFF) + 20, 1u, __ATOMIC_RELAXED, __HIP_MEMORY_SCOPE_WORKGROUP);
    }
}

__device__ __forceinline__ void p5_combine(Frame& F, const Args& A) {
    const int lane = F.lane, h = lane >> 3, c0 = (lane & 7) * 16;
    for (int m = F.gw; m < T; m += F.NGW) {
        const int cur = (m & (SEQ - 1)) >> 8, nsel = cur < 3 ? cur : 3, sb = (m * 8 + h) * 4;
        float ls[4]; float M = -__builtin_inff();
#pragma unroll
        for (int s = 0; s < 4; ++s) { const bool valid = (s == 3) || (s < nsel); ls[s] = valid ? WSP(float, WS_LSE)[sb + s] : -__builtin_inff(); M = fmaxf(M, ls[s]); }
        float acc[16]; float wsum = 0.f;
#pragma unroll
        for (int j = 0; j < 16; ++j) acc[j] = 0.f;
#pragma unroll
        for (int s = 0; s < 4; ++s) { const bool valid = (s == 3) || (s < nsel);
            if (valid) { const float w = __builtin_amdgcn_exp2f(ls[s] - M); wsum += w; const bf16_t* p = WSP(bf16_t, WS_PO) + (size_t)(sb + s) * 128 + c0;
                const u32x4 a = *(const u32x4*)p, bq = *(const u32x4*)(p + 8);
                acc[0] += w * bflo(a.x); acc[1] += w * bfhi(a.x); acc[2] += w * bflo(a.y); acc[3] += w * bfhi(a.y); acc[4] += w * bflo(a.z); acc[5] += w * bfhi(a.z); acc[6] += w * bflo(a.w); acc[7] += w * bfhi(a.w);
                acc[8] += w * bflo(bq.x); acc[9] += w * bfhi(bq.x); acc[10] += w * bflo(bq.y); acc[11] += w * bfhi(bq.y); acc[12] += w * bflo(bq.z); acc[13] += w * bfhi(bq.z); acc[14] += w * bflo(bq.w); acc[15] += w * bfhi(bq.w); } }
        const float iw = 1.f / wsum; float ss = 0.f;
#pragma unroll
        for (int j = 0; j < 16; ++j) { acc[j] *= iw; ss += acc[j] * acc[j]; }
        const float rstd = 1.f / sqrtf(wave_sum(ss) * (1.f / 1024.f) + NORM_EPS);
        const float* g = IN_F(3) + h * 128 + c0; bf16_t* op = WSP(bf16_t, WS_OCAT) + (size_t)m * DM + h * 128 + c0;
#pragma unroll
        for (int q = 0; q < 2; ++q) { const f32x4 g0 = *(const f32x4*)(g + 8 * q), g1 = *(const f32x4*)(g + 8 * q + 4); u32x4 w;
            w.x = cvt_pk_bf16(acc[8 * q + 0] * rstd * g0.x, acc[8 * q + 1] * rstd * g0.y); w.y = cvt_pk_bf16(acc[8 * q + 2] * rstd * g0.z, acc[8 * q + 3] * rstd * g0.w);
            w.z = cvt_pk_bf16(acc[8 * q + 4] * rstd * g1.x, acc[8 * q + 5] * rstd * g1.y); w.w = cvt_pk_bf16(acc[8 * q + 6] * rstd * g1.z, acc[8 * q + 7] * rstd * g1.w);
            *(u32x4*)(op + 8 * q) = w; }
        bf16_t* mp = WSP(bf16_t, WS_OCAT) + (size_t)m * DM + 1024 + lane * 16; const u32x4 a = *(const u32x4*)mp, bq = *(const u32x4*)(mp + 8);
        float f[16] = {bflo(a.x), bfhi(a.x), bflo(a.y), bfhi(a.y), bflo(a.z), bfhi(a.z), bflo(a.w), bfhi(a.w), bflo(bq.x), bfhi(bq.x), bflo(bq.y), bfhi(bq.y), bflo(bq.z), bfhi(bq.z), bflo(bq.w), bfhi(bq.w)};
        float s2 = 0.f;
#pragma unroll
        for (int j = 0; j < 16; ++j) s2 += f[j] * f[j];
        const float rstd2 = 1.f / sqrtf(wave_sum(s2) * (1.f / 1024.f) + NORM_EPS);
        const float* g2 = IN_F(8) + lane * 16;
#pragma unroll
        for (int q = 0; q < 2; ++q) { const f32x4 g0 = *(const f32x4*)(g2 + 8 * q), g1 = *(const f32x4*)(g2 + 8 * q + 4); u32x4 w;
            w.x = cvt_pk_bf16(f[8 * q + 0] * rstd2 * g0.x, f[8 * q + 1] * rstd2 * g0.y); w.y = cvt_pk_bf16(f[8 * q + 2] * rstd2 * g0.z, f[8 * q + 3] * rstd2 * g0.w);
            w.z = cvt_pk_bf16(f[8 * q + 4] * rstd2 * g1.x, f[8 * q + 5] * rstd2 * g1.y); w.w = cvt_pk_bf16(f[8 * q + 6] * rstd2 * g1.z, f[8 * q + 7] * rstd2 * g1.w);
            *(u32x4*)(mp + 8 * q) = w; }
    }
}

__device__ __forceinline__ void p7_router(Frame& F, const Args& A) {
    const int tid = F.tid, lane = F.lane, wave = F.wave, r32 = lane & 31, hi = lane >> 5;
    LAS unsigned* hist = (LAS unsigned*)(F.lds + ROWSID_OFF); LAS unsigned* basel = hist + 32; LAS float* rstd_s = (LAS float*)(F.lds + ROWSID_OFF + 256);
    if (blockIdx.x == 0) { unsigned* z = (unsigned*)(WSP(unsigned char, WS_H2Q) + (size_t)T * DM); z[tid] = 0u; }
    for (int grp = blockIdx.x; grp < T / 64; grp += F.G) {
        {
            LAS float* part = (LAS float*)F.lds;
            const bf16_t* ap = WSP(bf16_t, WS_WR) + (size_t)r32 * DM + wave * 256 + hi * 8;
            const bf16_t* bp0 = WSP(bf16_t, WS_X1) + (size_t)(grp * 64 + r32) * DM + wave * 256 + hi * 8; const bf16_t* bp1 = bp0 + (size_t)32 * DM;
            f32x16 a0 = {}, a1 = {};
#pragma unroll
            for (int ks = 0; ks < 16; ++ks) { const bf16x8 af = *(const bf16x8*)(ap + ks * 16);
                a0 = __builtin_amdgcn_mfma_f32_32x32x16_bf16(af, *(const bf16x8*)(bp0 + ks * 16), a0, 0, 0, 0);
                a1 = __builtin_amdgcn_mfma_f32_32x32x16_bf16(af, *(const bf16x8*)(bp1 + ks * 16), a1, 0, 0, 0); }
#pragma unroll
            for (int r = 0; r < 16; ++r) { part[((wave * 2 + 0) * 16 + r) * 64 + lane] = a0[r]; part[((wave * 2 + 1) * 16 + r) * 64 + lane] = a1[r]; }
        }
        for (int j = 0; j < 8; ++j) { const int tl = wave * 8 + j, m = grp * 64 + tl;
            const u32x2* xr = (const u32x2*)(WSP(bf16_t, WS_X1) + (size_t)m * DM) + lane; const f32x4* gr = (const f32x4*)IN_F(10) + lane;
            f32x4 v[8]; float sq = 0.f;
#pragma unroll
            for (int q = 0; q < 8; ++q) { const u32x2 w = xr[64 * q]; v[q] = (f32x4){bflo(w.x), bfhi(w.x), bflo(w.y), bfhi(w.y)}; sq += (v[q].x * v[q].x + v[q].y * v[q].y) + (v[q].z * v[q].z + v[q].w * v[q].w); }
            const float rstd = 1.f / sqrtf(wave_sum(sq) * (1.f / DM) + NORM_EPS);
            unsigned* q4 = (unsigned*)(WSP(unsigned char, WS_H2Q) + (size_t)m * DM) + lane;
#pragma unroll
            for (int q = 0; q < 8; ++q) { const f32x4 gg = gr[64 * q]; const float s16 = rstd * 16.f; q4[64 * q] = pk4_fp8(v[q].x * s16 * gg.x, v[q].y * s16 * gg.y, v[q].z * s16 * gg.z, v[q].w * s16 * gg.w); }
            if (lane == 0) rstd_s[tl] = rstd; }
        if (tid < 32) hist[tid] = 0u;
        __syncthreads();
        int e_[4] = {0, 0, 0, 0}; float g_[4] = {0.f, 0.f, 0.f, 0.f}; unsigned pl_[4] = {0u, 0u, 0u, 0u};
        const int tok = grp * 64 + (wave & 1) * 32 + r32;
        if (wave < 2) {
            f32x16 acc = {};
            { const LAS float* part = (const LAS float*)F.lds;
#pragma unroll
              for (int w8 = 0; w8 < 8; ++w8)
#pragma unroll
                  for (int r = 0; r < 16; ++r) acc[r] += part[((w8 * 2 + wave) * 16 + r) * 64 + lane]; }
            const float rs = rstd_s[wave * 32 + r32];
            float v[16];
#pragma unroll
            for (int r = 0; r < 16; ++r) v[r] = acc[r] * rs + IN_F(12)[att::crow(r, hi)];
            const float NEG = -__builtin_inff();
            float cv[8]; int ci[8];
#pragma unroll
            for (int k = 0; k < 4; ++k) { float bv = NEG; int bi = 0;
#pragma unroll
                for (int r = 0; r < 16; ++r) if (v[r] > bv) { bv = v[r]; bi = r; }
#pragma unroll
                for (int r = 0; r < 16; ++r) if (r == bi) v[r] = NEG;
                cv[k] = bv; ci[k] = att::crow(bi, hi); }
#pragma unroll
            for (int k = 0; k < 4; ++k) { cv[4 + k] = __shfl_xor(cv[k], 32); ci[4 + k] = __shfl_xor(ci[k], 32); }
#pragma unroll
            for (int k = 0; k < 4; ++k) { float bv = NEG; int bi = 0, be = 1 << 30;
#pragma unroll
                for (int c = 0; c < 8; ++c) if (cv[c] > bv || (cv[c] == bv && ci[c] < be)) { bv = cv[c]; bi = c; be = ci[c]; }
#pragma unroll
                for (int c = 0; c < 8; ++c) if (c == bi) cv[c] = NEG;
                g_[k] = bv; e_[k] = be; }
            const float e1 = __expf(g_[1] - g_[0]), e2 = __expf(g_[2] - g_[0]), e3 = __expf(g_[3] - g_[0]), inv = 1.f / (1.f + e1 + e2 + e3);
            g_[0] = inv; g_[1] = e1 * inv; g_[2] = e2 * inv; g_[3] = e3 * inv;
            if (hi == 0) {
#pragma unroll
                for (int k = 0; k < 4; ++k) pl_[k] = __hip_atomic_fetch_add(hist + e_[k], 1u, __ATOMIC_RELAXED, __HIP_MEMORY_SCOPE_WORKGROUP); }
        }
        __syncthreads();
        if (tid < 32) { const unsigned c = hist[tid]; basel[tid] = c ? __hip_atomic_fetch_add(F.ctl + CW_ECNT + tid, c, RLX_AGENT) : 0u; }
        __syncthreads();
        if (wave < 2 && hi == 0) {
#pragma unroll
            for (int k = 0; k < 4; ++k) { const int e = e_[k]; const unsigned p = basel[e] + pl_[k];
                WSP(int, WS_ELIST)[(size_t)e * T + p] = tok; WSP(float, WS_EGATE)[(size_t)e * T + p] = g_[k]; WSP(int, WS_DEST)[tok * 4 + k] = e | (int)(p << 8); } }
        __syncthreads();
    }
}

__device__ __forceinline__ void moe_tables(Frame& F) {
    LAS int* tab = (LAS int*)(F.lds + TAB_OFF);
    if (F.tid < 32) { const int lane = F.tid; const int c = (int)__hip_atomic_load(F.ctl + CW_ECNT + lane, RLX_AGENT); const int nt = (c + 255) >> 8; int inc = nt;
#pragma unroll
        for (int o = 1; o < 32; o <<= 1) { const int v = __shfl_up(inc, o); if (lane >= o) inc += v; }
        const int tb = inc - nt; tab[640 + lane] = c; tab[672 + lane] = tb;
        for (int j = 0; j < nt; ++j) { tab[tb + j] = lane; tab[320 + tb + j] = j * 256; }
        if (lane == 31) tab[704] = inc; }
    __syncthreads();
}

__device__ __forceinline__ void p10_final(Frame& F, const Args& A) {
    const LAS int* tab = (const LAS int*)(F.lds + TAB_OFF); const int lane = F.lane;
    for (int m = F.gw; m < T; m += F.NGW) {
        const u32x2* xr = (const u32x2*)(WSP(bf16_t, WS_X1) + (size_t)m * DM) + lane;
        f32x4 v[8];
#pragma unroll
        for (int j = 0; j < 8; ++j) { const u32x2 w = xr[64 * j]; v[j] = (f32x4){bflo(w.x), bfhi(w.x), bflo(w.y), bfhi(w.y)}; }
#pragma unroll
        for (int k = 0; k < 4; ++k) { const int d = WSP(int, WS_DEST)[m * 4 + k], e = d & 255, p = d >> 8; const size_t row = (size_t)tab[672 + e] * 256 + p;
            const unsigned* yr = (const unsigned*)(WSP(unsigned char, WS_Y) + row * DM) + lane;
#pragma unroll
            for (int j = 0; j < 8; ++j) { const int w = (int)yr[64 * j]; const f32x2 lo = __builtin_amdgcn_cvt_pk_f32_fp8(w, false), hi2 = __builtin_amdgcn_cvt_pk_f32_fp8(w, true);
                v[j].x += lo.x * (1.f / 64.f); v[j].y += lo.y * (1.f / 64.f); v[j].z += hi2.x * (1.f / 64.f); v[j].w += hi2.y * (1.f / 64.f); } }
        float s = 0.f;
#pragma unroll
        for (int j = 0; j < 8; ++j) s += (v[j].x * v[j].x + v[j].y * v[j].y) + (v[j].z * v[j].z + v[j].w * v[j].w);
        const float rstd = 1.f / sqrtf(wave_sum(s) * (1.f / DM) + NORM_EPS);
        const f32x4* gr = (const f32x4*)IN_F(17) + lane; f32x4* o = (f32x4*)(A.out + (size_t)m * DM) + lane;
#pragma unroll
        for (int j = 0; j < 8; ++j) o[64 * j] = v[j] * rstd * gr[64 * j];
    }
}

__global__ void __launch_bounds__(NWAVES * 64, 2) fwd_kernel(Args args) {
    extern __shared__ __attribute__((aligned(16))) unsigned char lds_raw[];
    Frame F;
    F.lds = (LAS unsigned char*)lds_raw; F.ldsg = (char*)lds_raw;
    F.MISC = (volatile LAS unsigned*)(F.lds + MISC_OFF);
    F.tid = threadIdx.x; F.lane = F.tid & 63; F.wave = __builtin_amdgcn_readfirstlane(F.tid >> 6);
    F.G = gridDim.x; F.gw = blockIdx.x * NWAVES + F.wave; F.NGW = F.G * NWAVES;
    const Args& A = args;
    F.ctl = (unsigned*)(A.ws + WS_CTL);
    for (int u = F.tid; u < 64; u += NWAVES * 64) F.MISC[u] = 0u;
    __syncthreads();
    const int lo = args.ph_lo, hi = args.ph_hi;
    const bool one = (hi - lo) > 1;
    XcdBarrier bar; bar.bar = F.ctl + CW_BAR; bar.x = 0; bar.st = nullptr;
    if (one) bar = xcd_barrier_post(F.ctl + CW_BAR, F.MISC + 8);
#ifndef PROBE_DUP
#define PROBE_DUP 0
#endif
#ifndef PH_MASK
#define PH_MASK 0x7ff
#endif
#define IN(k) (((PH_MASK >> (k)) & 1) && lo <= (k) && (k) < hi)
#define SEAM(k) do { if (IN(k) && IN((k) + 1)) xcd_barrier(bar); } while (0)
    LAS int* tab = (LAS int*)(F.lds + TAB_OFF);

    if (IN(0)) { p0_prologue(F, A); if (PROBE_DUP & 1) { xcd_barrier(bar); p0_prologue(F, A); } SEAM(0); }
    if (IN(1)) { pg8::Gemm g{WSP(bf16_t, WS_XN), WSP(bf16_t, WS_WIN), T, 4096, DM}; pg8::StaticOrder S; S.init(T, 4096, F.G, (int)blockIdx.x); pg8::EpiBf16 E{WSP(bf16_t, WS_P), NPROJ};
        pg8::gemm_phase<pg8::EpiBf16, pg8::StaticOrder, false>(F.lds, g, S, E); SEAM(1); }
    if (IN(2)) { p2_thin(F, A); SEAM(2); }
    if (IN(3)) {
        { pg8::Gemm g{WSP(bf16_t, WS_CQN), WSP(bf16_t, WS_WUQ), T, QFW, 512}; pg8::StaticOrder S; S.init(T, QFW, F.G, (int)blockIdx.x); pg8::EpiQRope E{WSP(bf16_t, WS_QF), WSP(float, WS_ROPE)};
          pg8::gemm_phase<pg8::EpiQRope, pg8::StaticOrder, false>(F.lds, g, S, E); }
        { pg8::Gemm g{WSP(bf16_t, WS_CKVN), WSP(bf16_t, WS_WUKV), T, KVW, 512}; pg8::StaticOrder S; S.init(T, KVW, F.G, (int)blockIdx.x); pg8::EpiBf16 E{WSP(bf16_t, WS_KV), KVW};
          pg8::gemm_phase<pg8::EpiBf16, pg8::StaticOrder, false>(F.lds, g, S, E); }
        p3_gating(F, A); SEAM(3); }
    if (IN(4)) { p4_setup(F);
        if (((blockIdx.x >> 3) & 1) == 0) {
            p4_moba_loop(F, A, 0, true); if (F.wave >= 4) conv_wave(F, A); __syncthreads(); }
        p4_mla_loop(F, A, 0);
        conv_wave(F, A); SEAM(4); }
    if (IN(5)) { p5_combine(F, A); SEAM(5); }
    if (IN(6)) { pg8::Gemm g{WSP(bf16_t, WS_OCAT), WSP(bf16_t, WS_WO), T, DM, DM}; pg8::StaticOrder S; S.init(T, DM, F.G, (int)blockIdx.x); pg8::EpiResBf16 E{IN_F(0), WSP(bf16_t, WS_X1)};
        pg8::gemm_phase<pg8::EpiResBf16, pg8::StaticOrder, false>(F.lds, g, S, E); SEAM(6); }
    if (IN(7)) { p7_router(F, A); SEAM(7); }
    if (IN(8)) { moe_tables(F);
        pg8::MoeOrder S; S.nM = tab[704]; S.nN = 2 * FF / 256; S.G = F.G; S.c = (int)blockIdx.x; S.tile_e = tab; S.tile_r0 = tab + 320; S.ecnt = tab + 640; S.elist = WSP(int, WS_ELIST); S.estride = (size_t)2 * FF * DM / 2;
        pg8::Gemm g{WSP(bf16_t, WS_H2Q), WSP(bf16_t, WS_W1), S.nM * 256, 2 * FF, DM / 2}; pg8::EpiSwiglu E{WSP(unsigned char, WS_ACT), IN_F(14), (LAS float*)(F.lds + PRE_OFF)};
        pg8::gemm_phase<pg8::EpiSwiglu, pg8::MoeOrder, true, true>(F.lds, g, S, E); SEAM(8); }
    if (IN(9)) { if (!IN(8)) moe_tables(F);
        pg8::MoeOrder S; S.nM = tab[704]; S.nN = DM / 256; S.G = F.G; S.c = (int)blockIdx.x; S.tile_e = tab; S.tile_r0 = tab + 320; S.ecnt = tab + 640; S.elist = WSP(int, WS_ELIST); S.estride = (size_t)DM * FF / 2;
        pg8::Gemm g{WSP(bf16_t, WS_ACT), WSP(bf16_t, WS_W2), S.nM * 256, DM, FF / 2}; pg8::EpiDown E{WSP(unsigned char, WS_Y), IN_F(16), WSP(float, WS_EGATE), tab + 640, (LAS float*)(F.lds + PRE_OFF)};
        pg8::gemm_phase<pg8::EpiDown, pg8::MoeOrder, false, true>(F.lds, g, S, E); SEAM(9); }
    if (IN(10)) { if (!IN(8)) moe_tables(F); p10_final(F, A); }
#undef IN
#undef SEAM
}

constexpr int NPH = 11;
extern "C" void kernel_launch(void* const* d_in, const int* in_sizes, int n_in, void* d_out, int out_size, void* d_ws, size_t ws_size, hipStream_t stream) {
    static int grid = 0;
    if (grid == 0) {
        if (n_in != 18 || out_size != T * DM || ws_size < WS_END) { fprintf(stderr, "kernel_launch: unexpected shapes (n_in %d out %d ws %zu need %zu)\n", n_in, out_size, ws_size, (size_t)WS_END); grid = -1; return; }
        int dev = 0, cus = 0, per_cu = 0;
        if (hipGetDevice(&dev) != hipSuccess || hipDeviceGetAttribute(&cus, hipDeviceAttributeMultiprocessorCount, dev) != hipSuccess) { grid = -1; return; }
        if (hipFuncSetAttribute((const void*)fwd_kernel, hipFuncAttributeMaxDynamicSharedMemorySize, LDS_BYTES) != hipSuccess) { fprintf(stderr, "kernel_launch: hipFuncSetAttribute failed\n"); grid = -1; return; }
        if (hipOccupancyMaxActiveBlocksPerMultiprocessor(&per_cu, (const void*)fwd_kernel, NWAVES * 64, LDS_BYTES) != hipSuccess || per_cu < 1)
            fprintf(stderr, "kernel_launch: occupancy query reports %d workgroups per CU\n", per_cu);
        (void)hipGetLastError();
        grid = cus;
    }
    if (grid < 0) return;
    (void)hipMemsetAsync((char*)d_ws + WS_CTL, 0, CTL_ZERO_BYTES, stream);
    Args a{};
    for (int i = 0; i < 18; ++i) a.in[i] = (const float*)d_in[i];
    a.out = (float*)d_out; a.ws = (unsigned char*)d_ws;
#if MK_N_LAUNCHES == 1
    a.ph_lo = 0; a.ph_hi = NPH;
    hipLaunchKernelGGL(fwd_kernel, dim3(grid), dim3(NWAVES * 64), LDS_BYTES, stream, a);
#else
    for (int p = 0; p < NPH; ++p) { a.ph_lo = p; a.ph_hi = p + 1; hipLaunchKernelGGL(fwd_kernel, dim3(grid), dim3(NWAVES * 64), LDS_BYTES, stream, a); }
#endif
}
```

```cpp
#include <hip/hip_runtime.h>
#include <cstdio>
#include <cstdint>

#ifndef MK_N_LAUNCHES
#define MK_N_LAUNCHES 1
#endif

constexpr int NBATCH = 2, SEQ = 8192, T = NBATCH * SEQ, DM = 2048;
constexpr int NPROJ = 4352;
constexpr int QFW = 1536, KVW = 2048;
constexpr int NE = 32, FF = 2048, TOPK = 4;
constexpr float NORM_EPS = 1e-5f;
constexpr int NPHASE = 12;

typedef unsigned short bf16_t;
typedef short bf16x8 __attribute__((ext_vector_type(8)));
typedef short s16x4 __attribute__((ext_vector_type(4)));
typedef float f32x4 __attribute__((ext_vector_type(4)));
typedef float f32x2 __attribute__((ext_vector_type(2)));
typedef float f32x16 __attribute__((ext_vector_type(16)));
typedef unsigned u32x4 __attribute__((ext_vector_type(4)));
typedef unsigned u32x2 __attribute__((ext_vector_type(2)));
#define LAS __attribute__((address_space(3)))
#define GAS __attribute__((address_space(1)))
#define RLX_AGENT __ATOMIC_RELAXED, __HIP_MEMORY_SCOPE_AGENT
#define LDS_WAIT() asm volatile("s_waitcnt lgkmcnt(0)" ::: "memory")
#define VM_WAIT() asm volatile("s_waitcnt vmcnt(0)" ::: "memory")
#define SBAR() __builtin_amdgcn_sched_barrier(0)

constexpr size_t MiB = 1u << 20;
constexpr size_t al(size_t x) { return (x + MiB - 1) / MiB * MiB; }
constexpr size_t WS_CTL = 0, CTL_ZERO_BYTES = 64 * 1024;
constexpr size_t WS_WIN = 1 * MiB;
constexpr size_t WS_WUQ = WS_WIN + al((size_t)NPROJ * DM * 2);
constexpr size_t WS_WUKV = WS_WUQ + al((size_t)QFW * 512 * 2);
constexpr size_t WS_WO = WS_WUKV + al((size_t)KVW * 512 * 2);
constexpr size_t WS_WR = WS_WO + al((size_t)DM * DM * 2);
constexpr size_t WS_W1 = WS_WR + al((size_t)NE * DM * 2);
constexpr size_t WS_W2 = WS_W1 + al((size_t)NE * 2 * FF * DM * 2);
constexpr size_t WS_ROPE = WS_W2 + al((size_t)NE * DM * FF * 2);
constexpr size_t WS_XN = WS_ROPE + al((size_t)SEQ * 64 * 4);
constexpr size_t WS_P = WS_XN + al((size_t)T * DM * 2);
constexpr size_t WS_CQN = WS_P + al((size_t)T * NPROJ * 2);
constexpr size_t WS_CKVN = WS_CQN + al((size_t)T * 512 * 2);
constexpr size_t WS_KR = WS_CKVN + al((size_t)T * 512 * 2);
constexpr size_t WS_KMEAN = WS_KR + al((size_t)T * 64 * 2);
constexpr size_t WS_QF = WS_KMEAN + al((size_t)512 * 128 * 4);
constexpr size_t WS_KV = WS_QF + al((size_t)T * QFW * 2);
constexpr size_t WS_LIST = WS_KV + al((size_t)T * KVW * 2);
constexpr size_t WS_PO = WS_LIST + al((size_t)512 * 8192 * 4);
constexpr size_t WS_LSE = WS_PO + al(((size_t)T * 32 + 1) * 128 * 2);
constexpr size_t WS_OCAT = WS_LSE + al(((size_t)T * 32 + 1) * 4);
constexpr size_t WS_X1 = WS_OCAT + al((size_t)T * DM * 2);
constexpr size_t WS_H2 = WS_X1 + al((size_t)T * DM * 4);
constexpr size_t WS_H2Q = WS_H2 + al((size_t)(T + 1) * DM * 2);
constexpr size_t WS_ELIST = WS_H2Q + al((size_t)(T + 1) * DM);
constexpr size_t WS_EGATE = WS_ELIST + al((size_t)NE * T * 4);
constexpr size_t WS_DEST = WS_EGATE + al((size_t)NE * T * 4);
constexpr size_t WS_ACT = WS_DEST + al((size_t)T * 4 * 4);
constexpr size_t WS_Y = WS_ACT + al((size_t)288 * 256 * FF * 2);
constexpr size_t WS_END = WS_Y + al((size_t)288 * 256 * DM * 2);
constexpr int CW_TMO = 0, CW_QUEUE = 64, CW_QUEUE2 = 320, CW_CQ = 448, CW_ECNT = 128, CW_MCNT = 1024, CW_BAR = 4096;

constexpr int RING_BYTES = 131072;
constexpr int MISC_OFF = RING_BYTES;
constexpr int TAB_OFF = RING_BYTES + 256;
constexpr int PRE_OFF = RING_BYTES + 4096;
constexpr int ROWSID_OFF = RING_BYTES + 8192;
constexpr int LDS_BYTES = RING_BYTES + 20480;

__device__ __forceinline__ unsigned cvt_pk_bf16(float lo, float hi) { unsigned r; asm volatile("v_cvt_pk_bf16_f32 %0, %1, %2" : "=v"(r) : "v"(lo), "v"(hi)); return r; }
typedef int i32x4 __attribute__((ext_vector_type(4)));
typedef int i32x8 __attribute__((ext_vector_type(8)));
__device__ __forceinline__ unsigned pk4_fp8(float a, float b, float c, float d) {
    a = __builtin_fminf(__builtin_fmaxf(a, -448.f), 448.f); b = __builtin_fminf(__builtin_fmaxf(b, -448.f), 448.f); c = __builtin_fminf(__builtin_fmaxf(c, -448.f), 448.f); d = __builtin_fminf(__builtin_fmaxf(d, -448.f), 448.f);
    int w = 0; w = __builtin_amdgcn_cvt_pk_fp8_f32(a, b, w, false); w = __builtin_amdgcn_cvt_pk_fp8_f32(c, d, w, true); return (unsigned)w;
}
__device__ __forceinline__ float bf2f(unsigned short b) { return __uint_as_float(((unsigned)b) << 16); }
__device__ __forceinline__ float bflo(unsigned w) { return __uint_as_float(w << 16); }
__device__ __forceinline__ float bfhi(unsigned w) { return __uint_as_float(w & 0xffff0000u); }
__device__ __forceinline__ float wave_sum(float v) {
#pragma unroll
    for (int o = 1; o < 64; o <<= 1) v += __shfl_xor(v, o);
    return v;
}

#define XB_TMO      128
#define XB_XCNT(j)  (256  + 64 * (j))
#define XB_XSUB(j)  (1280 + 64 * (j))
#define XB_XGEN(j)  (2304 + 64 * (j))
#define XB_TOP      3328
#define XB_TOPGEN   3392
#define XCD_BAR_WORDS 3456
#define XB_SPIN_CAP (1u << 22)
__device__ __forceinline__ unsigned xb_ld(unsigned* p)              { return __hip_atomic_load(p, __ATOMIC_RELAXED, __HIP_MEMORY_SCOPE_AGENT); }
__device__ __forceinline__ unsigned xb_add(unsigned* p, unsigned v) { return __hip_atomic_fetch_add(p, v, __ATOMIC_RELAXED, __HIP_MEMORY_SCOPE_AGENT); }
__device__ __forceinline__ unsigned xb_xcc_id() { return (unsigned)__builtin_amdgcn_s_getreg((3 << 11) | 20) & 0xFu; }
#define XB_SPIN(cond, bar) do { unsigned _sp = 0; while (cond) { __builtin_amdgcn_s_sleep(1); \
    if ((++_sp & 255u) == 0u) { if (xb_ld(&(bar)[XB_TMO])) break; if (_sp > XB_SPIN_CAP) { atomicAdd(&(bar)[XB_TMO], 1u); break; } } } } while (0)
struct XcdBarrier { unsigned* bar; unsigned x; volatile LAS unsigned* st; };
__device__ __forceinline__ XcdBarrier xcd_barrier_post(unsigned* bar, volatile LAS unsigned* st) {
    XcdBarrier b; b.bar = bar; b.x = xb_xcc_id(); b.st = st;
    if (threadIdx.x == 0) (void)xb_add(&bar[XB_XCNT(b.x)], 1u);
    return b;
}
__device__ __forceinline__ void xcd_barrier_complete(unsigned* bar, unsigned x, unsigned& nloc, unsigned& nx) {
    const unsigned G = gridDim.x * gridDim.y * gridDim.z;
    unsigned sum, cnt, mine, sp = 0u;
    for (;;) {
        sum = 0u; cnt = 0u; mine = 0u;
#pragma unroll
        for (unsigned j = 0; j < 16; ++j) { const unsigned c = xb_ld(&bar[XB_XCNT(j)]); sum += c; cnt += (c > 0u) ? 1u : 0u; mine = (j == x) ? c : mine; }
        if (sum == G) break;
        __builtin_amdgcn_s_sleep(1);
        if ((++sp & 255u) == 0u) { if (xb_ld(&bar[XB_TMO])) break; if (sp > XB_SPIN_CAP) { atomicAdd(&bar[XB_TMO], 1u); break; } }
    }
    nloc = mine > 0u ? mine : 1u; nx = cnt > 0u ? cnt : 1u;
}
__device__ __forceinline__ void xcd_barrier(const XcdBarrier& b) {
    asm volatile("s_waitcnt vmcnt(0)" ::: "memory");
    __syncthreads();
    if (threadIdx.x == 0) {
        unsigned* bar = b.bar;
        __builtin_amdgcn_s_waitcnt(0);
        unsigned nloc = b.st[0], nx = b.st[1];
        if (nloc == 0u) { xcd_barrier_complete(bar, b.x, nloc, nx); b.st[0] = nloc; b.st[1] = nx; }
        const unsigned old = xb_add(&bar[XB_XSUB(b.x)], 1u);
        const unsigned gen = old / nloc;
        if (old + 1u == (gen + 1u) * nloc) {
            __builtin_amdgcn_fence(__ATOMIC_RELEASE, "agent");
            asm volatile("s_waitcnt vmcnt(0)" ::: "memory");
            const unsigned og = xb_add(&bar[XB_TOP], 1u);
            const unsigned tg = og / nx;
            if (og + 1u == (tg + 1u) * nx) xb_add(&bar[XB_TOPGEN], 1u);
            else XB_SPIN(xb_ld(&bar[XB_TOPGEN]) == tg, bar);
            __builtin_amdgcn_fence(__ATOMIC_ACQUIRE, "agent");
            xb_add(&bar[XB_XGEN(b.x)], 1u);
            asm volatile("s_waitcnt vmcnt(0)" ::: "memory");
        } else {
            XB_SPIN(xb_ld(&bar[XB_XGEN(b.x)]) == gen, bar);
            __builtin_amdgcn_fence(__ATOMIC_ACQUIRE, "agent");
            asm volatile("s_waitcnt vmcnt(0)" ::: "memory");
        }
    }
    __syncthreads();
}

namespace pg8 {
constexpr int BM = 256, BK = 64, HALF = 128, HTB = HALF * BK * 2, STAGE_BYTES = 8 * HTB, NXCD = 8, WGM = 4;
__host__ __device__ __forceinline__ int lds_byte(int r, int c) { const int st = (r >> 4) * 2 + (c >> 5), rr = r & 15, cc = c & 31, ob = rr * 64 + cc * 2; return st * 1024 + (ob ^ (((ob >> 9) & 1) << 5)); }
__host__ __device__ __forceinline__ void stage_rc(int b, int& R, int& C) { const int st = b / 1024, sb = b % 1024, swz = sb ^ (((sb >> 9) & 1) << 5); R = (st >> 1) * 16 + swz / 64; C = (st & 1) * 32 + (swz % 64) / 2; }
__host__ __device__ __forceinline__ int perm32(int rho) { const int n = rho >> 4, i = rho & 15; return 8 * (i >> 2) + 4 * n + (i & 3); }

struct Unit { int pm, pn, e, r0; };
struct Gemm { const bf16_t* A; const bf16_t* Bt; int M, N, K; };

__device__ __forceinline__ bool order_next(int i, int G, int c, int nM, int nN, int& pm, int& pn) {
    const int nwg = nM * nN; const long L = (long)i * G + c; if (L >= nwg) return false;
    int wgid = (int)L; { const int q = nwg / NXCD, r = nwg % NXCD, xcd = wgid % NXCD, off = wgid / NXCD; wgid = (xcd < r ? xcd * (q + 1) : r * (q + 1) + (xcd - r) * q) + off; }
    const int nig = WGM * nN, gid = wgid / nig, fm = gid * WGM, gsz = (nM - fm) < WGM ? (nM - fm) : WGM;
    pm = fm + ((wgid % nig) % gsz); pn = (wgid % nig) / gsz; return true;
}
struct StaticOrder {
    int nM, nN, G, c;
    __device__ void init(int M, int N, int G_, int c_) { nM = M / BM; nN = N / BM; G = G_; c = c_; }
    __device__ __forceinline__ bool next(int i, Unit& u) const { u.e = 0; u.r0 = 0; return order_next(i, G, c, nM, nN, u.pm, u.pn); }
    __device__ __forceinline__ const char* b_ptr(const Gemm& g, const Unit& u) const { return (const char*)g.Bt + (size_t)u.pn * (size_t)BM * g.K * 2; }
    __device__ __forceinline__ unsigned row_off(const Unit&, int, int) const { return 0u; }
};
struct MoeOrder {
    int nM, nN, G, c; const LAS int* tile_e; const LAS int* tile_r0; const LAS int* ecnt; const int* elist; size_t estride;
    __device__ __forceinline__ bool next(int i, Unit& u) const { if (!order_next(i, G, c, nM, nN, u.pm, u.pn)) return false; u.e = __builtin_amdgcn_readfirstlane(tile_e[u.pm]); u.r0 = __builtin_amdgcn_readfirstlane(tile_r0[u.pm]); return true; }
    __device__ __forceinline__ const char* b_ptr(const Gemm& g, const Unit& u) const { return (const char*)g.Bt + ((size_t)u.e * estride + (size_t)u.pn * (size_t)BM * g.K) * 2; }
    __device__ __forceinline__ unsigned row_off(const Unit& u, int vrow, int K) const {
        const int idx = u.r0 + vrow; int tok = T; if (idx < ecnt[u.e]) tok = elist[(size_t)u.e * T + idx];
        return (unsigned)tok * (unsigned)(K * 2);
    }
};

template <class Epi, class Sched, bool GATHER, bool FP8 = false>
__device__ __forceinline__ void gemm_phase(LAS unsigned char* lds, const Gemm g, const Sched& S, const Epi& E) {
    const int tid = threadIdx.x, wid = __builtin_amdgcn_readfirstlane(tid >> 6), lane = tid & 63, wr = wid >> 2, wc = wid & 3, fr = lane & 15, fq = lane >> 4;
    const int K = g.K, nt = K / BK;
    unsigned voffA[2], voffB[2]; int RA[2];
#pragma unroll
    for (int i = 0; i < 2; ++i) { int R, C; stage_rc(tid * 16 + i * 8192, R, C); const int Rb = Epi::PERM ? ((R & ~31) + perm32(R & 31)) : R;
        RA[i] = R; voffA[i] = GATHER ? (unsigned)(C * 2) : (unsigned)(R * K + C) * 2u; voffB[i] = (unsigned)(Rb * K + C) * 2u; }
    const size_t kstep = (size_t)(BK * 2);
    const size_t hstep = (size_t)HALF * K * 2;
    const size_t tstep = 2 * hstep;
    const unsigned ldsw = (unsigned)wid * 1024u;
    const int aoff = lds_byte(wr * 64 + fr, fq * 8), boff = lds_byte(wc * 32 + fr, fq * 8);
    unsigned gc[2][2] = {{0u, 0u}, {0u, 0u}}, gn[2][2] = {{0u, 0u}, {0u, 0u}};
#define PG8_SA(b, h) (((b) * 2 + (h)) * HTB)
#define PG8_SB(b, h) ((4 + (b) * 2 + (h)) * HTB)
#define PG8_STAGE(bufoff, gbase, voff) do { _Pragma("unroll") for (int _i = 0; _i < 2; ++_i) \
        __builtin_amdgcn_global_load_lds((const unsigned*)((const char*)(gbase) + (voff)[_i]), (LAS unsigned*)(lds + (bufoff) + ldsw + _i * 8192), 16, 0, 0); } while (0)
#define PG8_STAGE_A(bufoff, gbase, h, NX) do { if constexpr (GATHER) { _Pragma("unroll") for (int _i = 0; _i < 2; ++_i) \
        __builtin_amdgcn_global_load_lds((const unsigned*)((const char*)(gbase) + ((NX) ? gn[h][_i] : gc[h][_i]) + voffA[_i]), (LAS unsigned*)(lds + (bufoff) + ldsw + _i * 8192), 16, 0, 0); } \
        else { PG8_STAGE(bufoff, (const char*)(gbase) + (h) * hstep, voffA); } } while (0)
#define PG8_LD8(base) __builtin_shufflevector(*(const LAS i32x4*)(base), *(const LAS i32x4*)((base) + 1024), 0, 1, 2, 3, 4, 5, 6, 7)
#define PG8_LDA(dst, b, h) do { if constexpr (FP8) { _Pragma("unroll") for (int m = 0; m < 4; ++m) dst##8[m] = PG8_LD8(lds + PG8_SA(b, h) + aoff + m * 2048); } \
        else { _Pragma("unroll") for (int m = 0; m < 4; ++m) _Pragma("unroll") for (int k = 0; k < 2; ++k) dst[m][k] = *(const LAS bf16x8*)(lds + PG8_SA(b, h) + aoff + m * 2048 + k * 1024); } } while (0)
#define PG8_LDB(dst, b, h) do { if constexpr (FP8) { _Pragma("unroll") for (int n = 0; n < 2; ++n) dst##8[n] = PG8_LD8(lds + PG8_SB(b, h) + boff + n * 2048); } \
        else { _Pragma("unroll") for (int n = 0; n < 2; ++n) _Pragma("unroll") for (int k = 0; k < 2; ++k) dst[n][k] = *(const LAS bf16x8*)(lds + PG8_SB(b, h) + boff + n * 2048 + k * 1024); } } while (0)
#define PG8_MMA(ai, bj, At, Bt) do { __builtin_amdgcn_s_setprio(1); _Pragma("unroll") for (int m = 0; m < 4; ++m) _Pragma("unroll") for (int n = 0; n < 2; ++n) { \
        if constexpr (FP8) { asm volatile("v_mfma_scale_f32_16x16x128_f8f6f4 %0, %1, %2, %0, %3, %3 op_sel_hi:[0,0,0]" : "+v"(acc[ai][bj][m][n]) : "v"(Bt##8[n]), "v"(At##8[m]), "v"(sc7f)); } \
        else { _Pragma("unroll") for (int k = 0; k < 2; ++k) acc[ai][bj][m][n] = __builtin_amdgcn_mfma_f32_16x16x32_bf16(Bt[n][k], At[m][k], acc[ai][bj][m][n], 0, 0, 0); } } \
        __builtin_amdgcn_s_setprio(0); } while (0)
#define PG8_WAIT_V(n) asm volatile("s_waitcnt vmcnt(" #n ")" ::: "memory")
#define PG8_WAIT_L(n) asm volatile("s_waitcnt lgkmcnt(" #n ")" ::: "memory")
#define PG8_BAR __builtin_amdgcn_s_barrier()
#define PG8_SCHED __builtin_amdgcn_sched_barrier(0)
#define PG8_GLOAD(dst, u) do { if constexpr (GATHER) { _Pragma("unroll") for (int _h = 0; _h < 2; ++_h) _Pragma("unroll") for (int _i = 0; _i < 2; ++_i) dst[_h][_i] = S.row_off(u, _h * HALF + RA[_i], K); } } while (0)
    Unit cur, nxt; int ui = 0;
    if (!S.next(0, cur)) return;
    f32x4 acc[2][2][4][2];
#pragma unroll
    for (int a = 0; a < 2; ++a)
#pragma unroll
        for (int b = 0; b < 2; ++b)
#pragma unroll
            for (int m = 0; m < 4; ++m)
#pragma unroll
                for (int n = 0; n < 2; ++n) acc[a][b][m][n] = (f32x4){0.f, 0.f, 0.f, 0.f};
    bf16x8 At[4][2], B0[2][2], B1[2][2]; i32x8 At8[4], B08[2], B18[2];
    int sc7f = 0x7f7f7f7f; asm volatile("" : "+v"(sc7f));
    const char* cA = GATHER ? (const char*)g.A : (const char*)g.A + (size_t)cur.pm * tstep; const char* cB = S.b_ptr(g, cur);
    PG8_GLOAD(gc, cur);
    if constexpr (GATHER) { PG8_WAIT_V(0); }
    PG8_STAGE(PG8_SB(0, 0), cB, voffB); PG8_STAGE(PG8_SB(0, 1), cB + hstep, voffB); PG8_STAGE_A(PG8_SA(0, 0), cA, 0, false); PG8_STAGE_A(PG8_SA(0, 1), cA, 1, false);
    if (wr == 1) PG8_BAR;
    PG8_WAIT_V(2); PG8_BAR;
    PG8_STAGE(PG8_SB(1, 0), cB + kstep, voffB); PG8_STAGE_A(PG8_SA(1, 0), cA + kstep, 0, false); PG8_STAGE(PG8_SB(1, 1), cB + hstep + kstep, voffB);
    PG8_WAIT_V(6); PG8_BAR;
    for (;;) {
        const bool has_next = S.next(ui + 1, nxt);
        const char* nA = has_next ? (GATHER ? (const char*)g.A : (const char*)g.A + (size_t)nxt.pm * tstep) : cA; const char* nB = has_next ? S.b_ptr(g, nxt) : cB;
        if constexpr (GATHER) { if (has_next) { PG8_GLOAD(gn, nxt); } else { gn[0][0] = gc[0][0]; gn[0][1] = gc[0][1]; gn[1][0] = gc[1][0]; gn[1][1] = gc[1][1]; } }
        if constexpr (Epi::PREF) E.prefetch(cur, ui);
        for (int t = 0; t < nt; t += 2) {
            const bool last = (t == nt - 2);
            const char* a1 = cA + (size_t)(t + 1) * kstep;
            const char* a2 = last ? nA : cA + (size_t)(t + 2) * kstep; const char* b2 = last ? nB : cB + (size_t)(t + 2) * kstep;
            const char* a3 = a2 + kstep; const char* b3 = b2 + kstep;
            PG8_LDB(B0, 0, 0); PG8_LDB(B1, 0, 1); PG8_SCHED; PG8_LDA(At, 0, 0); PG8_STAGE_A(PG8_SA(1, 1), a1, 1, false);
            PG8_WAIT_V(8); PG8_WAIT_L(0); PG8_BAR; PG8_MMA(0, 0, At, B0); PG8_MMA(0, 1, At, B1); PG8_BAR; PG8_SCHED;
            PG8_LDA(At, 0, 1); PG8_STAGE(PG8_SB(0, 0), b2, voffB); PG8_STAGE(PG8_SB(0, 1), b2 + hstep, voffB); PG8_STAGE_A(PG8_SA(0, 0), a2, 0, last);
            PG8_WAIT_V(8); PG8_WAIT_L(0); PG8_BAR; PG8_MMA(1, 0, At, B0); PG8_MMA(1, 1, At, B1); PG8_BAR; PG8_SCHED;
            PG8_LDB(B0, 1, 0); PG8_LDB(B1, 1, 1); PG8_SCHED; PG8_LDA(At, 1, 0); PG8_STAGE_A(PG8_SA(0, 1), a2, 1, last);
            PG8_WAIT_V(8); PG8_WAIT_L(0); PG8_BAR; PG8_MMA(0, 0, At, B0); PG8_MMA(0, 1, At, B1); PG8_BAR; PG8_SCHED;
            PG8_LDA(At, 1, 1); PG8_STAGE(PG8_SB(1, 0), b3, voffB); PG8_STAGE(PG8_SB(1, 1), b3 + hstep, voffB); PG8_STAGE_A(PG8_SA(1, 0), a3, 0, last);
            PG8_WAIT_V(8); PG8_WAIT_L(0); PG8_BAR; PG8_MMA(1, 0, At, B0); PG8_MMA(1, 1, At, B1); PG8_BAR; PG8_SCHED;
        }
        if constexpr (FP8) asm volatile("s_nop 15\n\ts_nop 15" ::: "memory");
        if (wr == 0) PG8_BAR;
        { int fr_ = fr, fq_ = fq; if constexpr (FP8) asm volatile("" : "+v"(fr_), "+v"(fq_));
          E(acc, cur, wr, wc, fr_, fq_, ui); }
        if (!has_next) break;
#pragma unroll
        for (int a = 0; a < 2; ++a)
#pragma unroll
            for (int b = 0; b < 2; ++b)
#pragma unroll
                for (int m = 0; m < 4; ++m)
#pragma unroll
                    for (int n = 0; n < 2; ++n) acc[a][b][m][n] = (f32x4){0.f, 0.f, 0.f, 0.f};
        cur = nxt; cA = nA; cB = nB; ++ui;
        if constexpr (GATHER) { gc[0][0] = gn[0][0]; gc[0][1] = gn[0][1]; gc[1][0] = gn[1][0]; gc[1][1] = gn[1][1]; }
        if (wr == 1) PG8_BAR;
    }
    PG8_WAIT_V(0);
    PG8_BAR;
#undef PG8_SA
#undef PG8_SB
#undef PG8_STAGE
#undef PG8_STAGE_A
#undef PG8_LDA
#undef PG8_LD8
#undef PG8_LDB
#undef PG8_MMA
#undef PG8_WAIT_V
#undef PG8_WAIT_L
#undef PG8_BAR
#undef PG8_SCHED
#undef PG8_GLOAD
}

struct EpiBf16 {
    static constexpr bool PERM = true; static constexpr bool PREF = false;
    bf16_t* O; int ldc;
    __device__ __forceinline__ void operator()(const f32x4 (&acc)[2][2][4][2], const Unit& u, int wr, int wc, int fr, int fq, int ui) const {
        const int row0 = u.pm * BM + wr * 64 + fr, col0 = u.pn * BM + wc * 32 + 8 * fq;
#pragma unroll
        for (int ai = 0; ai < 2; ++ai)
#pragma unroll
            for (int m = 0; m < 4; ++m) { bf16_t* rowp = O + (size_t)(row0 + ai * HALF + m * 16) * ldc + col0;
#pragma unroll
                for (int bj = 0; bj < 2; ++bj) { const f32x4 v0 = acc[ai][bj][m][0], v1 = acc[ai][bj][m][1];
                    u32x4 w; w.x = cvt_pk_bf16(v0[0], v0[1]); w.y = cvt_pk_bf16(v0[2], v0[3]); w.z = cvt_pk_bf16(v1[0], v1[1]); w.w = cvt_pk_bf16(v1[2], v1[3]);
                    *(u32x4*)(rowp + bj * HALF) = w; } }
    }
};
struct EpiQRope {
    static constexpr bool PERM = true; static constexpr bool PREF = false;
    bf16_t* O; const float* ropetab;
    __device__ __forceinline__ void operator()(const f32x4 (&acc)[2][2][4][2], const Unit& u, int wr, int wc, int fr, int fq, int ui) const {
        const int row0 = u.pm * BM + wr * 64 + fr, col0 = u.pn * BM + wc * 32 + 8 * fq;
#pragma unroll
        for (int bj = 0; bj < 2; ++bj) { const int col = col0 + bj * HALF, hc = col % 192; const bool rope = hc >= 128; const int i0 = rope ? (hc - 128) >> 1 : 0;
#pragma unroll
            for (int ai = 0; ai < 2; ++ai)
#pragma unroll
                for (int m = 0; m < 4; ++m) { const int row = row0 + ai * HALF + m * 16, pos = row & (SEQ - 1);
                    f32x4 v0 = acc[ai][bj][m][0], v1 = acc[ai][bj][m][1];
                    const f32x4 cs = *(const f32x4*)(ropetab + (size_t)pos * 32 + i0), sn = *(const f32x4*)(ropetab + (size_t)SEQ * 32 + (size_t)pos * 32 + i0);
                    if (rope) { f32x4 a, b;
                        a[0] = v0[0] * cs[0] - v0[1] * sn[0]; a[1] = v0[1] * cs[0] + v0[0] * sn[0]; a[2] = v0[2] * cs[1] - v0[3] * sn[1]; a[3] = v0[3] * cs[1] + v0[2] * sn[1];
                        b[0] = v1[0] * cs[2] - v1[1] * sn[2]; b[1] = v1[1] * cs[2] + v1[0] * sn[2]; b[2] = v1[2] * cs[3] - v1[3] * sn[3]; b[3] = v1[3] * cs[3] + v1[2] * sn[3];
                        v0 = a; v1 = b; }
                    u32x4 w; w.x = cvt_pk_bf16(v0[0], v0[1]); w.y = cvt_pk_bf16(v0[2], v0[3]); w.z = cvt_pk_bf16(v1[0], v1[1]); w.w = cvt_pk_bf16(v1[2], v1[3]);
                    *(u32x4*)(O + (size_t)row * QFW + col) = w;
                    asm volatile("" ::: "memory"); } }
    }
};
struct EpiResBf16 {
    static constexpr bool PERM = true; static constexpr bool PREF = false;
    const float* base; bf16_t* C;
    __device__ __forceinline__ void operator()(const f32x4 (&acc)[2][2][4][2], const Unit& u, int wr, int wc, int fr, int fq, int ui) const {
        const int row0 = u.pm * BM + wr * 64 + fr, col0 = u.pn * BM + wc * 32 + 8 * fq;
#pragma unroll
        for (int ai = 0; ai < 2; ++ai)
#pragma unroll
            for (int m = 0; m < 4; ++m) { const size_t off = (size_t)(row0 + ai * HALF + m * 16) * DM + col0;
#pragma unroll
                for (int bj = 0; bj < 2; ++bj) { const f32x4 v0 = *(const f32x4*)(base + off + bj * HALF) + acc[ai][bj][m][0], v1 = *(const f32x4*)(base + off + bj * HALF + 4) + acc[ai][bj][m][1];
                    u32x4 w; w.x = cvt_pk_bf16(v0[0], v0[1]); w.y = cvt_pk_bf16(v0[2], v0[3]); w.z = cvt_pk_bf16(v1[0], v1[1]); w.w = cvt_pk_bf16(v1[2], v1[3]);
                    *(u32x4*)(C + off + bj * HALF) = w; }
                asm volatile("" ::: "memory"); }
    }
};
struct EpiSwiglu {
    static constexpr bool PERM = true; static constexpr bool PREF = true;
    unsigned char* O; const float* b1; LAS float* pf;
    __device__ __forceinline__ void prefetch(const Unit& u, int ui) const {
        const int t = threadIdx.x, w = __builtin_amdgcn_readfirstlane(t >> 6);
        const float* src = b1 + (size_t)u.e * (2 * FF) + u.pn * HALF + (t & 127) + ((t & 128) ? FF : 0);
        __builtin_amdgcn_global_load_lds((const unsigned*)src, (LAS unsigned*)(pf + (ui & 1) * 512 + w * 64), 4, 0, 0);
    }
    __device__ __forceinline__ void operator()(const f32x4 (&acc)[2][2][4][2], const Unit& u, int wr, int wc, int fr, int fq, int ui) const {
        const int row0 = u.pm * BM + wr * 64 + fr, cl = u.pn * HALF + wc * 32 + 8 * fq;
        const LAS float* bp = pf + (ui & 1) * 512 + wc * 32 + 8 * fq;
        const f32x4 bg0 = *(const LAS f32x4*)bp, bg1 = *(const LAS f32x4*)(bp + 4), bl0 = *(const LAS f32x4*)(bp + 128), bl1 = *(const LAS f32x4*)(bp + 132);
        constexpr float DS = 1.0f / 16384.0f;
#pragma unroll
        for (int ai = 0; ai < 2; ++ai)
#pragma unroll
            for (int m = 0; m < 4; ++m) { unsigned char* rowp = O + (size_t)(row0 + ai * HALF + m * 16) * FF + cl;
                f32x4 r[2];
#pragma unroll
                for (int n = 0; n < 2; ++n) { const f32x4 gv = acc[ai][0][m][n] * DS + (n ? bg1 : bg0), lv = acc[ai][1][m][n] * DS + (n ? bl1 : bl0);
#pragma unroll
                    for (int h = 0; h < 2; ++h) {
                        f32x2 g2 = {fminf(gv[2 * h], 7.0f), fminf(gv[2 * h + 1], 7.0f)}, l2 = {fminf(fmaxf(lv[2 * h], -7.0f), 7.0f), fminf(fmaxf(lv[2 * h + 1], -7.0f), 7.0f)};
                        const f32x2 t2 = g2 * (f32x2){-1.702f * 1.4426950408889634f, -1.702f * 1.4426950408889634f};
                        const f32x2 d2 = (f32x2){__builtin_amdgcn_exp2f(t2.x), __builtin_amdgcn_exp2f(t2.y)} + (f32x2){1.0f, 1.0f};
                        const f32x2 q2 = g2 * (f32x2){__builtin_amdgcn_rcpf(d2.x), __builtin_amdgcn_rcpf(d2.y)};
                        const f32x2 r2 = q2 * (l2 * (f32x2){4.0f, 4.0f} + (f32x2){4.0f, 4.0f});
                        r[n][2 * h] = r2.x; r[n][2 * h + 1] = r2.y; } }
                int w0 = 0, w1 = 0;
                w0 = __builtin_amdgcn_cvt_pk_fp8_f32(r[0][0], r[0][1], w0, false); w0 = __builtin_amdgcn_cvt_pk_fp8_f32(r[0][2], r[0][3], w0, true);
                w1 = __builtin_amdgcn_cvt_pk_fp8_f32(r[1][0], r[1][1], w1, false); w1 = __builtin_amdgcn_cvt_pk_fp8_f32(r[1][2], r[1][3], w1, true);
                u32x2 w; w.x = (unsigned)w0; w.y = (unsigned)w1;
                *(u32x2*)rowp = w; }
    }
};
struct EpiDown {
    static constexpr bool PERM = true; static constexpr bool PREF = true;
    unsigned char* O; const float* b2; const float* egate; const LAS int* ecnt; LAS float* pf;
    __device__ __forceinline__ void prefetch(const Unit& u, int ui) const {
        const int t = threadIdx.x, w = __builtin_amdgcn_readfirstlane(t >> 6);
        const float* src = (t < 256) ? b2 + (size_t)u.e * DM + u.pn * BM + t : egate + (size_t)u.e * T + u.r0 + (t - 256);
        __builtin_amdgcn_global_load_lds((const unsigned*)src, (LAS unsigned*)(pf + (ui & 1) * 512 + w * 64), 4, 0, 0);
    }
    __device__ __forceinline__ void operator()(const f32x4 (&acc)[2][2][4][2], const Unit& u, int wr, int wc, int fr, int fq, int ui) const {
        const int rl0 = wr * 64 + fr, col0 = u.pn * BM + wc * 32 + 8 * fq; const int cnt = ecnt[u.e];
        const LAS float* pb = pf + (ui & 1) * 512; const LAS float* bp = pb + wc * 32 + 8 * fq;
        f32x4 bv[2][2];
#pragma unroll
        for (int bj = 0; bj < 2; ++bj)
#pragma unroll
            for (int n = 0; n < 2; ++n) bv[bj][n] = *(const LAS f32x4*)(bp + bj * HALF + 4 * n);
#pragma unroll
        for (int ai = 0; ai < 2; ++ai)
#pragma unroll
            for (int m = 0; m < 4; ++m) { const int rl = rl0 + ai * HALF + m * 16, idx = u.r0 + rl; float gt = 0.f; if (idx < cnt) gt = 64.f * pb[256 + rl];
                unsigned char* rowp = O + (size_t)(u.pm * BM + rl) * DM + col0;
#pragma unroll
                for (int bj = 0; bj < 2; ++bj) { const f32x4 v0 = (acc[ai][bj][m][0] * (1.0f / 4096.0f) + bv[bj][0]) * gt, v1 = (acc[ai][bj][m][1] * (1.0f / 4096.0f) + bv[bj][1]) * gt;
                    u32x2 w; w.x = pk4_fp8(v0[0], v0[1], v0[2], v0[3]); w.y = pk4_fp8(v1[0], v1[1], v1[2], v1[3]);
                    *(u32x2*)(rowp + bj * HALF) = w; } }
    }
};
}

namespace att {
constexpr int SHM_V = 64 * 128 * 2;
constexpr float THR = 8.f;
__device__ __forceinline__ int v_st(int k, int c) { const int kk = (k & ~0xC) | ((k & 4) << 1) | ((k & 8) >> 1); return ((kk >> 3) * 4 + (c >> 5)) * 512 + ((kk & 7) * 32 + (c & 31)) * 2; }
__device__ __forceinline__ int v_rd_base(int lane) { return ((lane & 3) << 3) | (((lane >> 2) & 3) << 6) | (((lane >> 4) & 1) << 5) | (((lane >> 5) & 1) << 8); }
constexpr int v_rd_off(int d0, int ks, int half) { return d0 * 512 + ks * 4096 + half * 2048; }
__device__ __forceinline__ int crow(int r, int hi) { return (r & 3) + 8 * (r >> 2) + 4 * hi; }
__device__ __forceinline__ unsigned cvtpk(float lo, float hi) { unsigned r; asm volatile("v_cvt_pk_bf16_f32 %0, %1, %2" : "=v"(r) : "v"(lo), "v"(hi)); return r; }
__device__ __forceinline__ void mask_tile(f32x16& p0, f32x16& p1, int dq) {
    const float NEG = -__builtin_inff();
#pragma unroll
    for (int r = 0; r < 16; ++r) {
        const int c = (r & 3) + 8 * (r >> 2);
        if (dq - c < 0) p0[r] = NEG;
        if (dq - c - 32 < 0) p1[r] = NEG;
    }
}
template <int DQK> __device__ __forceinline__ void partialSM(f32x16& p0, f32x16& p1, float& m_reg, float& mn, float& alpha) {
    constexpr float SCALE = DQK == 192 ? 0.07216878364870322f : 0.08838834764831845f;
    float pmax = p0[0];
#pragma unroll
    for (int r = 1; r < 16; ++r) pmax = fmaxf(pmax, p0[r]);
#pragma unroll
    for (int r = 0; r < 16; ++r) pmax = fmaxf(pmax, p1[r]);
    { auto rr = __builtin_amdgcn_permlane32_swap(__float_as_uint(pmax), __float_as_uint(pmax), false, false);
      pmax = fmaxf(__uint_as_float(rr[0]), __uint_as_float(rr[1])); }
    constexpr float C2 = 1.4426950408889634f * SCALE;
    const bool need = (pmax - m_reg) * SCALE > THR;
    mn = need ? fmaxf(m_reg, pmax) : m_reg; alpha = need ? __builtin_amdgcn_exp2f((m_reg - mn) * C2) : 1.f; m_reg = mn;
    const float mnL = -mn * C2;
#pragma unroll
    for (int r = 0; r < 16; ++r) p0[r] = fmaf(p0[r], C2, mnL);
#pragma unroll
    for (int r = 0; r < 16; ++r) p1[r] = fmaf(p1[r], C2, mnL);
#pragma unroll
    for (int r = 0; r < 16; ++r) p0[r] = __builtin_amdgcn_exp2f(p0[r]);
}
__device__ __forceinline__ void finishSM(f32x16& p0, f32x16& p1, float alpha, float& l_reg, bf16x8& pa0, bf16x8& pa1, bf16x8& pa2, bf16x8& pa3) {
#pragma unroll
    for (int r = 0; r < 16; ++r) p1[r] = __builtin_amdgcn_exp2f(p1[r]);
    float ps = 0;
#pragma unroll
    for (int r = 0; r < 16; ++r) ps += p0[r];
#pragma unroll
    for (int r = 0; r < 16; ++r) ps += p1[r];
    { auto rr = __builtin_amdgcn_permlane32_swap(__float_as_uint(ps), __float_as_uint(ps), false, false);
      ps = __uint_as_float(rr[0]) + __uint_as_float(rr[1]); }
    l_reg = l_reg * alpha + ps;
#define PK4(P, B_, OUT) do { unsigned a0 = cvtpk(P[B_+0], P[B_+1]), a1 = cvtpk(P[B_+2], P[B_+3]);                          \
        unsigned b0 = cvtpk(P[B_+4], P[B_+5]), b1 = cvtpk(P[B_+6], P[B_+7]);                                             \
        auto r0 = __builtin_amdgcn_permlane32_swap(a0, b0, false, false); auto r1 = __builtin_amdgcn_permlane32_swap(a1, b1, false, false); \
        u32x4 w = {r0[0], r1[0], r0[1], r1[1]}; OUT = *reinterpret_cast<bf16x8*>(&w); } while (0)
    PK4(p0, 0, pa0); PK4(p0, 8, pa1); PK4(p1, 0, pa2); PK4(p1, 8, pa3);
#undef PK4
}
template <int DQK, int KB>
__device__ __forceinline__ void qkt(f32x16& p0, f32x16& p1, const char* K_lds, int r32, int hi, const bf16x8* qr) {
    constexpr int ROWB = DQK * 2, SHM_K = 64 * ROWB;
    p0 = f32x16{}; p1 = f32x16{};
    const char* kb[4];
#pragma unroll
    for (int dd = 0; dd < 4; ++dd) kb[dd] = K_lds + KB * SHM_K + r32 * ROWB + (((dd * 16 + hi * 8) * 2) ^ ((r32 & 7) << 4));
#pragma unroll
    for (int d0 = 0; d0 < DQK / 16; ++d0) { const char* a = kb[d0 & 3] + (d0 >> 2) * 128;
        bf16x8 b0 = *reinterpret_cast<const bf16x8*>(a);
        bf16x8 b1 = *reinterpret_cast<const bf16x8*>(a + 32 * ROWB);
        p0 = __builtin_amdgcn_mfma_f32_32x32x16_bf16(b0, qr[d0], p0, 0, 0, 0);
        p1 = __builtin_amdgcn_mfma_f32_32x32x16_bf16(b1, qr[d0], p1, 0, 0, 0); }
}
template <int VB>
__device__ __forceinline__ void pv_tile(f32x16* o, int vb0, bf16x8 pa0, bf16x8 pa1, bf16x8 pa2, bf16x8 pa3) {
#define TRRD(dst, off) asm volatile("ds_read_b64_tr_b16 %0, %1 offset:%2" : "=&v"(dst) : "v"(vb0), "i"(off) : "memory")
#define PV_D0(d0) do { s16x4 l0, l1, l2, l3, h0, h1, h2, h3; constexpr int b_ = VB * SHM_V + v_rd_off(d0, 0, 0); \
        TRRD(l0, b_); TRRD(h0, b_ + 2048); TRRD(l1, b_ + 4096); TRRD(h1, b_ + 6144); TRRD(l2, b_ + 8192); TRRD(h2, b_ + 10240); TRRD(l3, b_ + 12288); TRRD(h3, b_ + 14336); \
        asm volatile("s_waitcnt lgkmcnt(0)" ::: "memory"); SBAR();   \
        o[d0] = __builtin_amdgcn_mfma_f32_32x32x16_bf16(pa0, (bf16x8){l0[0], l0[1], l0[2], l0[3], h0[0], h0[1], h0[2], h0[3]}, o[d0], 0, 0, 0);   \
        o[d0] = __builtin_amdgcn_mfma_f32_32x32x16_bf16(pa1, (bf16x8){l1[0], l1[1], l1[2], l1[3], h1[0], h1[1], h1[2], h1[3]}, o[d0], 0, 0, 0);   \
        o[d0] = __builtin_amdgcn_mfma_f32_32x32x16_bf16(pa2, (bf16x8){l2[0], l2[1], l2[2], l2[3], h2[0], h2[1], h2[2], h2[3]}, o[d0], 0, 0, 0);   \
        o[d0] = __builtin_amdgcn_mfma_f32_32x32x16_bf16(pa3, (bf16x8){l3[0], l3[1], l3[2], l3[3], h3[0], h3[1], h3[2], h3[3]}, o[d0], 0, 0, 0); } while (0)
    PV_D0(0); PV_D0(1); PV_D0(2); PV_D0(3);
#undef PV_D0
#undef TRRD
}

constexpr int NRING = 3;
template <int DQK, bool BIAS>
__device__ __forceinline__ void attn_unit(char* lds, const bf16x8* qr, const bf16_t* Kn, int kpitch, const bf16_t* Kr, const bf16_t* Vp, int vpitch,
                                          int kb0, int NT, int qpos, int qlo, bool causal, float biasraw, f32x16* o, float& m_reg, float& l_reg) {
    constexpr int ROWB = DQK * 2, SHM_K = 64 * ROWB;
    const int tid = threadIdx.x, wid = __builtin_amdgcn_readfirstlane(tid >> 6), lane = tid & 63, r32 = lane & 31, hi = lane >> 5;
    char* V_lds = lds; char* K_lds = lds + NRING * SHM_V;
    float* ws = (float*)(lds + NRING * SHM_V + NRING * SHM_K) + wid * 64; float* al_l = ws + 32;
    const int sr = tid >> 4, sc = (tid & 15) * 8, vst0 = v_st(sr, sc), vst1 = v_st(32 + sr, sc), kws = sr * ROWB + ((sc * 2) ^ ((sr & 7) << 4));
    const int rr_ = tid >> 3, rc = (tid & 7) * 8, kws2 = rr_ * ROWB + 256 + ((rc * 2) ^ ((rr_ & 7) << 4));
    const int vb0 = (int)(uintptr_t)V_lds + v_rd_base(lane);
    const unsigned goff = (unsigned)(sr * (int)kpitch + sc) * 2u, goff2 = (unsigned)(rr_ * 64 + rc) * 2u;
    bf16x8 st_k0, st_k1, st_k2 = {}, st_v0, st_v1;
#define A_SLOAD(kb) do { const char* kt_ = (const char*)Kn + (size_t)(kb) * kpitch * 2; const char* vt_ = (const char*)Vp + (size_t)(kb) * vpitch * 2; \
        st_v0 = *(const bf16x8*)(vt_ + goff); st_v1 = *(const bf16x8*)(vt_ + (size_t)32 * vpitch * 2 + goff); \
        st_k0 = *(const bf16x8*)(kt_ + goff); st_k1 = *(const bf16x8*)(kt_ + (size_t)32 * kpitch * 2 + goff); \
        if constexpr (DQK == 192) st_k2 = *(const bf16x8*)((const char*)Kr + (size_t)(kb) * 128 + goff2); } while (0)
#define A_SWRITE(bf) do { *(bf16x8*)(K_lds + (bf) * SHM_K + kws) = st_k0; *(bf16x8*)(K_lds + (bf) * SHM_K + kws + 32 * ROWB) = st_k1; \
        if constexpr (DQK == 192) *(bf16x8*)(K_lds + (bf) * SHM_K + kws2) = st_k2; \
        *(bf16x8*)(V_lds + (bf) * SHM_V + vst0) = st_v0; *(bf16x8*)(V_lds + (bf) * SHM_V + vst1) = st_v1; } while (0)
#define A_RESC(a) do { if (__any((a) < 1.f)) { if (hi == 0) al_l[r32] = (a); asm volatile("s_waitcnt lgkmcnt(0)" ::: "memory");              \
        _Pragma("unroll") for (int d_ = 0; d_ < 4; ++d_) _Pragma("unroll") for (int r = 0; r < 16; ++r) o[d_][r] *= al_l[crow(r, hi)]; } } while (0)
#define A_BAR() do { asm volatile("s_waitcnt lgkmcnt(0)" ::: "memory"); __builtin_amdgcn_s_barrier(); asm volatile("" ::: "memory"); } while (0)
    m_reg = -1e30f; l_reg = 0.f;
#pragma unroll
    for (int d = 0; d < 4; ++d) o[d] = f32x16{};
    A_SLOAD(kb0); VM_WAIT(); A_SWRITE(0);
    if (NT > 1) { A_SLOAD(kb0 + 64); VM_WAIT(); A_SWRITE(1); }
    __syncthreads();
    if (wid >= 4) A_BAR();
#define A_STEP(t, BUF) do { const int kb = kb0 + (t) * 64;                                                            \
        if ((t) + 2 < NT) A_SLOAD(kb + 128);                                                                          \
        f32x16 p0, p1; SBAR(); qkt<DQK, BUF>(p0, p1, K_lds, r32, hi, qr);                                             \
        if constexpr (BIAS) { const float bl = biasraw * (float)((t) * 64 + 4 * hi);                                  \
            _Pragma("unroll") for (int r = 0; r < 16; ++r) { const float bc = fmaf(biasraw, (float)((r & 3) + 8 * (r >> 2)), bl); p0[r] += bc; p1[r] += bc + 32.f * biasraw; } } \
        if (causal && kb + 63 > qlo) mask_tile(p0, p1, qpos - kb - 4 * hi);                                           \
        A_BAR();                                                                                                      \
        float mn, alpha; partialSM<DQK>(p0, p1, m_reg, mn, alpha);                                                    \
        A_RESC(alpha);                                                                                                \
        bf16x8 pa0, pa1, pa2, pa3; finishSM(p0, p1, alpha, l_reg, pa0, pa1, pa2, pa3); SBAR();                        \
        pv_tile<BUF>(o, vb0, pa0, pa1, pa2, pa3);                                                                     \
        if ((t) + 2 < NT) { A_SWRITE(((BUF) + 2) % NRING); }                                                          \
        A_BAR(); } while (0)
    int t = 0;
    for (; t + 2 < NT; t += 3) { A_STEP(t, 0); A_STEP(t + 1, 1); A_STEP(t + 2, 2); }
    if (t < NT) { A_STEP(t, 0); if (t + 1 < NT) A_STEP(t + 1, 1); }
    if (wid < 4) A_BAR();
#undef A_STEP
#undef A_BAR
#undef A_RESC
#undef A_SWRITE
#undef A_SLOAD
}
}

constexpr int NWAVES = 8;
struct Args { const float* in[18]; float* out; unsigned char* ws; int ph_lo, ph_hi; };
struct Frame {
    LAS unsigned char* lds; char* ldsg;
    volatile LAS unsigned* MISC;
    unsigned* ctl;
    int tid, lane, wave, G, gw, NGW;
};
#define IN_F(i) (A.in[i])
#define WSP(T_, off) ((T_*)(A.ws + (off)))

template <int MODE> __device__ __forceinline__ int drow(int n) {
    if (MODE == 1) { const int h = n / 192, nl = n - h * 192; return nl < 128 ? n : h * 192 + 128 + ((nl - 128) & 31) * 2 + ((nl - 128) >> 5); }
    if (MODE == 2) { return n < FF ? ((n >> 7) * 256 + (n & 127)) : (((n - FF) >> 7) * 256 + 128 + ((n - FF) & 127)); }
    return n;
}
template <int MODE> __device__ __forceinline__ void p0_transpose_item(const float* W, int K, int N, bf16_t* WT, LAS float* scr, int item, int lane, const float* kscale = nullptr) {
    const int nblk = N / 32, kb = item / nblk, nb = item % nblk, k0 = 64 * kb, n0 = 32 * nb;
#pragma unroll 8
    for (int i = 0; i < 32; ++i) { const int kk = 2 * i + (lane >> 5); float v = W[(size_t)(k0 + kk) * N + n0 + (lane & 31)]; if (kscale) v *= kscale[k0 + kk]; scr[kk * 33 + (lane & 31)] = v; }
    LDS_WAIT(); asm volatile("" ::: "memory");
    const int c = lane & 7;
#pragma unroll
    for (int j = 0; j < 4; ++j) { const int n = (lane >> 3) + 8 * j; const LAS float* s = scr + (8 * c) * 33 + n;
        u32x4 o; o.x = cvt_pk_bf16(s[0 * 33], s[1 * 33]); o.y = cvt_pk_bf16(s[2 * 33], s[3 * 33]); o.z = cvt_pk_bf16(s[4 * 33], s[5 * 33]); o.w = cvt_pk_bf16(s[6 * 33], s[7 * 33]);
        *(u32x4*)(WT + (size_t)drow<MODE>(n0 + n) * K + k0 + 8 * c) = o; }
    LDS_WAIT(); asm volatile("" ::: "memory");
}
__device__ __forceinline__ void cv_load(const float* W, int N, int nblk, int item, int lane, f32x4 (&tv)[16]) {
    const int kb = item / nblk, nb = item - kb * nblk; const float* p = W + (size_t)(64 * kb + 16 * (lane >> 4)) * N + 64 * nb + 4 * (lane & 15);
#pragma unroll
    for (int i = 0; i < 16; ++i) tv[i] = __builtin_nontemporal_load((const f32x4*)(p + (size_t)i * N));
}
template <int MODE> __device__ __forceinline__ void cv_finish(const f32x4 (&tv)[16], int K, int nblk, unsigned char* WT, int item, int lane) {
    const int kb = item / nblk, nb = item - kb * nblk, k0 = 64 * kb + 16 * (lane >> 4), n0 = 64 * nb + 4 * (lane & 15);
    unsigned D[16];
#pragma unroll
    for (int i = 0; i < 16; ++i) { const f32x2 a = (f32x2){tv[i].x, tv[i].y} * (f32x2){1024.f, 1024.f}, b = (f32x2){tv[i].z, tv[i].w} * (f32x2){1024.f, 1024.f};
        D[i] = pk4_fp8(a.x, a.y, b.x, b.y); }
    unsigned O[4][4];
#pragma unroll
    for (int q = 0; q < 4; ++q) { const unsigned a = D[4 * q], b = D[4 * q + 1], c = D[4 * q + 2], d = D[4 * q + 3];
        const unsigned t0 = __builtin_amdgcn_perm(b, a, 0x05010400u), t1 = __builtin_amdgcn_perm(b, a, 0x07030602u), u0 = __builtin_amdgcn_perm(d, c, 0x05010400u), u1 = __builtin_amdgcn_perm(d, c, 0x07030602u);
        O[0][q] = __builtin_amdgcn_perm(u0, t0, 0x05040100u); O[1][q] = __builtin_amdgcn_perm(u0, t0, 0x07060302u); O[2][q] = __builtin_amdgcn_perm(u1, t1, 0x05040100u); O[3][q] = __builtin_amdgcn_perm(u1, t1, 0x07060302u); }
#pragma unroll
    for (int j = 0; j < 4; ++j) { u32x4 o; o.x = O[j][0]; o.y = O[j][1]; o.z = O[j][2]; o.w = O[j][3];
        __builtin_nontemporal_store(o, (u32x4*)(WT + (size_t)drow<MODE>(n0 + j) * K + k0)); }
}
template <int MODE> __device__ __forceinline__ void cv_run4(const float* W, int K, int N, unsigned char* WT, int item0, int lane) {
    const int nblk = N / 64; f32x4 ta[16];
#pragma unroll 1
    for (int j = 0; j < 4; ++j) { cv_load(W, N, nblk, item0 + j, lane, ta); cv_finish<MODE>(ta, K, nblk, WT, item0 + j, lane); }
}
template <bool Q8> __device__ __forceinline__ void rms_row_to_bf16(const float* xrow, const float* g, bf16_t* orow, unsigned char* qrow, int lane) {
    const f32x4* xr = (const f32x4*)xrow + lane; const f32x4* gr = (const f32x4*)g + lane;
    f32x4 v[8]; float s = 0.f;
#pragma unroll
    for (int j = 0; j < 8; ++j) { v[j] = __builtin_nontemporal_load(xr + 64 * j); s += (v[j].x * v[j].x + v[j].y * v[j].y) + (v[j].z * v[j].z + v[j].w * v[j].w); }
    const float rstd = 1.f / sqrtf(wave_sum(s) * (1.f / DM) + NORM_EPS);
    u32x2* o8 = (u32x2*)orow + lane; unsigned* q4 = (unsigned*)qrow + lane;
#pragma unroll
    for (int j = 0; j < 8; ++j) { const f32x4 gg = gr[64 * j]; const float a = v[j].x * rstd * gg.x, b = v[j].y * rstd * gg.y, c = v[j].z * rstd * gg.z, d = v[j].w * rstd * gg.w;
        u32x2 w; w.x = cvt_pk_bf16(a, b); w.y = cvt_pk_bf16(c, d); o8[64 * j] = w;
        if constexpr (Q8) q4[64 * j] = pk4_fp8(a * 16.f, b * 16.f, c * 16.f, d * 16.f); }
}
__device__ __forceinline__ void p0_prologue(Frame& F, const Args& A) {
    LAS float* scr = (LAS float*)(F.lds + F.wave * 16384);
    constexpr int I_IN = 32 * 130, I_UQ = 8 * 48, I_UKV = 8 * 64, I_O = 32 * 64, I_R = 32;
    constexpr int I_SMALL = I_IN + I_UQ + I_UKV + I_O + I_R;
    for (int it = F.gw; it < I_SMALL; it += F.NGW) {
        int r = it;
        if (r < I_IN) { p0_transpose_item<0>(IN_F(2), DM, 4160, WSP(bf16_t, WS_WIN), scr, r, F.lane); continue; } r -= I_IN;
        if (r < I_UQ) { p0_transpose_item<1>(IN_F(6), 512, QFW, WSP(bf16_t, WS_WUQ), scr, r, F.lane); continue; } r -= I_UQ;
        if (r < I_UKV) { p0_transpose_item<0>(IN_F(7), 512, KVW, WSP(bf16_t, WS_WUKV), scr, r, F.lane); continue; } r -= I_UKV;
        if (r < I_O) { p0_transpose_item<0>(IN_F(9), DM, DM, WSP(bf16_t, WS_WO), scr, r, F.lane); continue; } r -= I_O;
        p0_transpose_item<0>(IN_F(11), DM, NE, WSP(bf16_t, WS_WR), scr, r, F.lane, IN_F(10));
    }
    for (int i = F.gw * 64 + F.lane; i < SEQ * 32; i += F.NGW * 64) { const int t = i >> 5, f = i & 31;
        const double inv = exp(-(double)(2 * f) / 64.0 * 9.210340371976184); double s, c; sincos((double)t * inv, &s, &c);
        WSP(float, WS_ROPE)[i] = (float)c; WSP(float, WS_ROPE)[SEQ * 32 + i] = (float)s; }
    for (int m = F.gw; m < T; m += F.NGW) rms_row_to_bf16<false>(IN_F(0) + (size_t)m * DM, IN_F(1), WSP(bf16_t, WS_XN) + (size_t)m * DM, nullptr, F.lane);
}

__device__ __forceinline__ void p2_thin(Frame& F, const Args& A) {
    const int lane = F.lane;
    for (int m = F.gw; m < T; m += F.NGW) {
        const bf16_t* prow = WSP(bf16_t, WS_P) + (size_t)m * NPROJ;
#pragma unroll
        for (int w = 0; w < 2; ++w) {
            const u32x4 v = *(const u32x4*)(prow + 3072 + w * 512 + lane * 8);
            float f[8] = {bflo(v.x), bfhi(v.x), bflo(v.y), bfhi(v.y), bflo(v.z), bfhi(v.z), bflo(v.w), bfhi(v.w)};
            float s = 0.f;
#pragma unroll
            for (int j = 0; j < 8; ++j) s += f[j] * f[j];
            const float rstd = 1.f / sqrtf(wave_sum(s) * (1.f / 512.f) + NORM_EPS);
            const float* g = (w ? IN_F(5) : IN_F(4)) + lane * 8; const f32x4 g0 = *(const f32x4*)g, g1 = *(const f32x4*)(g + 4);
            u32x4 o; o.x = cvt_pk_bf16(f[0] * rstd * g0.x, f[1] * rstd * g0.y); o.y = cvt_pk_bf16(f[2] * rstd * g0.z, f[3] * rstd * g0.w);
            o.z = cvt_pk_bf16(f[4] * rstd * g1.x, f[5] * rstd * g1.y); o.w = cvt_pk_bf16(f[6] * rstd * g1.z, f[7] * rstd * g1.w);
            *(u32x4*)((w ? WSP(bf16_t, WS_CKVN) : WSP(bf16_t, WS_CQN)) + (size_t)m * 512 + lane * 8) = o;
        }
    }
    for (int grp = blockIdx.x; grp < T / 64; grp += F.G) {
        const int r32 = lane & 31, hi = lane >> 5, wave = F.wave; LAS float* part = (LAS float*)F.lds;
        __syncthreads();
        { const bf16_t* ap = WSP(bf16_t, WS_WIN) + (size_t)(4096 + r32) * DM + wave * 256 + hi * 8;
          const bf16_t* bp = WSP(bf16_t, WS_XN) + (size_t)(grp * 64 + r32) * DM + wave * 256 + hi * 8;
          f32x16 c00 = {}, c01 = {}, c10 = {}, c11 = {};
#pragma unroll 4
          for (int ks = 0; ks < 16; ++ks) { const bf16x8 a0 = *(const bf16x8*)(ap + ks * 16), a1 = *(const bf16x8*)(ap + (size_t)32 * DM + ks * 16);
              const bf16x8 b0 = *(const bf16x8*)(bp + ks * 16), b1 = *(const bf16x8*)(bp + (size_t)32 * DM + ks * 16);
              c00 = __builtin_amdgcn_mfma_f32_32x32x16_bf16(a0, b0, c00, 0, 0, 0); c01 = __builtin_amdgcn_mfma_f32_32x32x16_bf16(a1, b0, c01, 0, 0, 0);
              c10 = __builtin_amdgcn_mfma_f32_32x32x16_bf16(a0, b1, c10, 0, 0, 0); c11 = __builtin_amdgcn_mfma_f32_32x32x16_bf16(a1, b1, c11, 0, 0, 0); }
#pragma unroll
          for (int r = 0; r < 16; ++r) { part[((wave * 4 + 0) * 16 + r) * 64 + lane] = c00[r]; part[((wave * 4 + 1) * 16 + r) * 64 + lane] = c01[r];
                                         part[((wave * 4 + 2) * 16 + r) * 64 + lane] = c10[r]; part[((wave * 4 + 3) * 16 + r) * 64 + lane] = c11[r]; } }
        __syncthreads();
        if (wave < 2) { f32x16 xa = {}, xb = {};
#pragma unroll 1
            for (int w8 = 0; w8 < 8; ++w8)
#pragma unroll
                for (int r = 0; r < 16; ++r) { xa[r] += part[((w8 * 4 + wave * 2 + 0) * 16 + r) * 64 + lane]; xb[r] += part[((w8 * 4 + wave * 2 + 1) * 16 + r) * 64 + lane]; }
            const int m = grp * 64 + wave * 32 + r32, pos = m & (SEQ - 1); bf16_t* kr = WSP(bf16_t, WS_KR) + (size_t)m * 64;
#pragma unroll
            for (int r = 0; r < 16; ++r) { const int i = att::crow(r, hi); const float c = WSP(float, WS_ROPE)[pos * 32 + i], sn = WSP(float, WS_ROPE)[SEQ * 32 + pos * 32 + i];
                *(unsigned*)(kr + 2 * i) = cvt_pk_bf16(xa[r] * c - xb[r] * sn, xb[r] * c + xa[r] * sn); } }
    }
    __syncthreads();
    for (int it = F.gw; it < 512; it += F.NGW) {
        const int bh = it >> 5, blk = it & 31, b = bh >> 3, h = bh & 7;
        const bf16_t* base = WSP(bf16_t, WS_P) + (size_t)(b * SEQ + blk * 256 + (lane >> 4)) * NPROJ + 1024 + h * 128 + (lane & 15) * 8;
        float a[8] = {0.f, 0.f, 0.f, 0.f, 0.f, 0.f, 0.f, 0.f};
#pragma unroll 8
        for (int r = 0; r < 64; ++r) { const u32x4 v = *(const u32x4*)(base + (size_t)(4 * r) * NPROJ);
            a[0] += bflo(v.x); a[1] += bfhi(v.x); a[2] += bflo(v.y); a[3] += bfhi(v.y); a[4] += bflo(v.z); a[5] += bfhi(v.z); a[6] += bflo(v.w); a[7] += bfhi(v.w); }
#pragma unroll
        for (int j = 0; j < 8; ++j) { a[j] += __shfl_xor(a[j], 16); a[j] += __shfl_xor(a[j], 32); a[j] *= (1.f / 256.f); }
        if (lane < 16) { float* o = WSP(float, WS_KMEAN) + (size_t)it * 128 + lane * 8; *(f32x4*)o = (f32x4){a[0], a[1], a[2], a[3]}; *(f32x4*)(o + 4) = (f32x4){a[4], a[5], a[6], a[7]}; }
    }
}

__device__ __forceinline__ void p3_gating(Frame& F, const Args& A) {
    constexpr int KMP = 132;
    LAS float* km = (LAS float*)F.lds;
    const int lane = F.lane, r32 = lane & 31, hi = lane >> 5;
    for (int item = blockIdx.x; item < 256; item += F.G) {
        const int bh = item >> 4, chunk = item & 15, b = bh >> 3, h = bh & 7;
        __syncthreads();
        for (int i = F.tid; i < 32 * 32; i += 512) *(LAS f32x4*)(km + (i >> 5) * KMP + (i & 31) * 4) = ((const f32x4*)(WSP(float, WS_KMEAN) + (size_t)bh * 32 * 128))[i];
        __syncthreads();
        const int pos0 = chunk * 512 + F.wave * 64, cur = __builtin_amdgcn_readfirstlane(pos0 >> 8);
        bf16x8 ah[8], al[8];
#pragma unroll
        for (int ks = 0; ks < 8; ++ks) { const LAS float* kp = km + r32 * KMP + ks * 16 + hi * 8; const f32x4 k0 = *(const LAS f32x4*)kp, k1 = *(const LAS f32x4*)(kp + 4);
            u32x4 wh; wh.x = cvt_pk_bf16(k0.x, k0.y); wh.y = cvt_pk_bf16(k0.z, k0.w); wh.z = cvt_pk_bf16(k1.x, k1.y); wh.w = cvt_pk_bf16(k1.z, k1.w);
            u32x4 wl; wl.x = cvt_pk_bf16(k0.x - bflo(wh.x), k0.y - bfhi(wh.x)); wl.y = cvt_pk_bf16(k0.z - bflo(wh.y), k0.w - bfhi(wh.y));
            wl.z = cvt_pk_bf16(k1.x - bflo(wh.z), k1.y - bfhi(wh.z)); wl.w = cvt_pk_bf16(k1.z - bflo(wh.w), k1.w - bfhi(wh.w));
            ah[ks] = __builtin_bit_cast(bf16x8, wh); al[ks] = __builtin_bit_cast(bf16x8, wl); }
        const float NEG = -__builtin_inff();
        int selg[2][3];
#pragma unroll
        for (int g2 = 0; g2 < 2; ++g2) {
            const bf16_t* qp = WSP(bf16_t, WS_P) + (size_t)(b * SEQ + pos0 + g2 * 32 + r32) * NPROJ + h * 128 + hi * 8;
            f32x16 acc = {};
#pragma unroll
            for (int ks = 0; ks < 8; ++ks) { const bf16x8 qf = *(const bf16x8*)(qp + ks * 16);
                acc = __builtin_amdgcn_mfma_f32_32x32x16_bf16(ah[ks], qf, acc, 0, 0, 0); acc = __builtin_amdgcn_mfma_f32_32x32x16_bf16(al[ks], qf, acc, 0, 0, 0); }
            float v[16];
#pragma unroll
            for (int r = 0; r < 16; ++r) v[r] = (att::crow(r, hi) < cur) ? acc[r] : NEG;
            float cv[6]; int ci[6];
#pragma unroll
            for (int k = 0; k < 3; ++k) { float bv = NEG; int bi = 0;
#pragma unroll
                for (int r = 0; r < 16; ++r) if (v[r] > bv) { bv = v[r]; bi = r; }
#pragma unroll
                for (int r = 0; r < 16; ++r) if (r == bi) v[r] = NEG;
                cv[k] = bv; ci[k] = att::crow(bi, hi); }
#pragma unroll
            for (int k = 0; k < 3; ++k) { cv[3 + k] = __shfl_xor(cv[k], 32); ci[3 + k] = __shfl_xor(ci[k], 32); }
#pragma unroll
            for (int k = 0; k < 3; ++k) { float bv = NEG; int bc = 0, be = 1 << 30;
#pragma unroll
                for (int c = 0; c < 6; ++c) if (cv[c] > bv || (cv[c] == bv && cv[c] > NEG && ci[c] < be)) { bv = cv[c]; bc = c; be = ci[c]; }
#pragma unroll
                for (int c = 0; c < 6; ++c) if (c == bc) cv[c] = NEG;
                selg[g2][k] = (bv > NEG) ? be : -1; }
        }
        const int pos = pos0 + lane;
        int sel[3] = {hi ? selg[1][0] : selg[0][0], hi ? selg[1][1] : selg[0][1], hi ? selg[1][2] : selg[0][2]};
        int mycnt = 0;
        for (int n = 0; n < cur; ++n) { const bool p = (sel[0] == n) || (sel[1] == n) || (sel[2] == n); const unsigned long long mk = __ballot(p); if (lane == n) mycnt = __popcll(mk); }
        unsigned* mc = F.ctl + CW_MCNT + bh * 32;
        int mybase = 0; if (mycnt > 0) mybase = (int)__hip_atomic_fetch_add(mc + lane, (unsigned)mycnt, RLX_AGENT);
        for (int n = 0; n < cur; ++n) { const bool p = (sel[0] == n) || (sel[1] == n) || (sel[2] == n); const unsigned long long mk = __ballot(p);
            const int bs = __shfl(mybase, n);
            if (p) { const int rank = __popcll(mk & ((1ull << lane) - 1ull)); const int sl = (sel[0] == n) ? 0 : ((sel[1] == n) ? 1 : 2);
                WSP(int, WS_LIST)[(size_t)(bh * 32 + n) * 8192 + bs + rank] = pos | (sl << 13); } }
    }
}

constexpr int CV_I_W1E = 32 * 64, CV_I_W2E = 32 * 32, CV_NITEMS = NE * CV_I_W1E + NE * CV_I_W2E, CV_NGRP = CV_NITEMS / 4;
__device__ __forceinline__ void conv_wave(Frame& F, const Args& A, volatile LAS unsigned* done = nullptr) {
    for (;;) {
        if (done) { if (__builtin_amdgcn_readfirstlane((int)*done) >= 4) break; }
        unsigned u = 0u; if (F.lane == 0) u = __hip_atomic_fetch_add(F.ctl + CW_CQ, 1u, RLX_AGENT);
        const int c = __builtin_amdgcn_readfirstlane((int)u);
        if (c >= CV_NGRP) break;
        const int r0 = c * 4;
        if (r0 < NE * CV_I_W1E) { const int e = r0 / CV_I_W1E;
            cv_run4<2>(IN_F(13) + (size_t)e * DM * 2 * FF, DM, 2 * FF, WSP(unsigned char, WS_W1) + (size_t)e * 2 * FF * DM, r0 - e * CV_I_W1E, F.lane); }
        else { const int r = r0 - NE * CV_I_W1E, e = r / CV_I_W2E;
            cv_run4<0>(IN_F(15) + (size_t)e * FF * DM, FF, DM, WSP(unsigned char, WS_W2) + (size_t)e * DM * FF, r - e * CV_I_W2E, F.lane); }
    }
}

constexpr int PO_DUMP = T * 32;
__device__ __forceinline__ void p4_setup(Frame& F) {
    LAS int* cntl = (LAS int*)(F.lds + PRE_OFF + 2048);
    cntl[F.tid] = (int)__hip_atomic_load(F.ctl + CW_MCNT + F.tid, RLX_AGENT);
    __syncthreads();
}
__device__ __forceinline__ void p4_mla_loop(Frame& F, const Args& A, const int qo) {
    const int tid = F.tid, lane = F.lane, wid = F.wave;
    char* lds = F.ldsg;
    for (;;) {
        __syncthreads();
        if (tid == 0) F.MISC[16] = __hip_atomic_fetch_add(F.ctl + CW_QUEUE + qo, 1u, RLX_AGENT);
        __syncthreads();
        const int it = __builtin_amdgcn_readfirstlane((int)F.MISC[16]);
        if (it >= 512) break;
        int ln = lane; asm volatile("" : "+v"(ln)); const int r32 = ln & 31, hi = ln >> 5;
        const int qb = 31 - (it >> 4), bh = it & 15, b = bh >> 3, h = bh & 7;
        const int m0 = b * SEQ + qb * 256 + wid * 32;
        bf16x8 qr[12];
        { const bf16_t* qp = WSP(bf16_t, WS_QF) + (size_t)(m0 + r32) * QFW + h * 192 + hi * 8;
#pragma unroll
          for (int d0 = 0; d0 < 12; ++d0) qr[d0] = *(const bf16x8*)(qp + d0 * 16); }
        f32x16 o[4]; float m_reg, l_reg;
        att::attn_unit<192, false>(lds, qr, WSP(bf16_t, WS_KV) + (size_t)b * SEQ * KVW + h * 256, KVW, WSP(bf16_t, WS_KR) + (size_t)b * SEQ * 64, WSP(bf16_t, WS_KV) + (size_t)b * SEQ * KVW + h * 256 + 128, KVW,
                                   0, (qb + 1) * 4, qb * 256 + wid * 32 + r32, qb * 256 + wid * 32, true, 0.f, o, m_reg, l_reg);
        float* ws = (float*)(lds + att::NRING * att::SHM_V + att::NRING * 64 * 384) + wid * 64;
        if (hi == 0) ws[r32] = l_reg; LDS_WAIT();
        const char* Ow = (const char*)(WSP(bf16_t, WS_OCAT) + (size_t)(b * SEQ + qb * 256 + wid * 32) * DM + 1024 + h * 128);
        const unsigned loff = (unsigned)((4 * hi) * DM + r32) * 2u;
#pragma unroll
        for (int r = 0; r < 16; ++r) { const int orow = att::crow(r, hi); const float rl = __builtin_amdgcn_rcpf(ws[orow]);
            const char* rb = Ow + (size_t)((r & 3) + 8 * (r >> 2)) * DM * 2;
#pragma unroll
            for (int d0 = 0; d0 < 4; ++d0) { const float v = o[d0][r] * rl; const float vn = __shfl_xor(v, 1);
                if ((r32 & 1) == 0) *(unsigned*)(rb + loff + d0 * 64) = cvt_pk_bf16(v, vn); } }
    }
}
__device__ __forceinline__ void p4_moba_loop(Frame& F, const Args& A, const int qo, const bool cvmode) {
    const int tid = F.tid, lane = F.lane, wid = F.wave;
    LAS int* cntl = (LAS int*)(F.lds + PRE_OFF + 2048); LAS int* rowsid = (LAS int*)(F.lds + ROWSID_OFF);
    char* lds = F.ldsg;
    for (;;) {
        __syncthreads();
        if (tid == 0) { F.MISC[17] = __hip_atomic_fetch_add(F.ctl + CW_QUEUE2 + qo, 1u, RLX_AGENT); F.MISC[20] = 0u; }
        __syncthreads();
        const int it = __builtin_amdgcn_readfirstlane((int)F.MISC[17]);
        if (it >= 512) break;
        int ln = lane; asm volatile("" : "+v"(ln)); const int r32 = ln & 31, hi = ln >> 5;
        const int n = it >> 4, bh = it & 15, b = bh >> 3, h = bh & 7, L = bh * 32 + n;
        const int cnt = __builtin_amdgcn_readfirstlane(cntl[L]);
        char* V_lds = lds + 65536; char* K_lds = lds;
        const bf16_t* kvb = WSP(bf16_t, WS_P) + (size_t)(b * SEQ + n * 256) * NPROJ + h * 128;
        {
            int t2 = tid; asm volatile("" : "+v"(t2));
            const int sr = t2 >> 4, sc = (t2 & 15) * 8, vst0 = att::v_st(sr, sc), vst1 = att::v_st(32 + sr, sc), kws = sr * 256 + ((sc * 2) ^ ((sr & 7) << 4));
            const unsigned goff = (unsigned)(sr * NPROJ + sc) * 2u;
#pragma unroll
            for (int j = 0; j < 4; ++j) { const char* kt = (const char*)(kvb + 1024) + (size_t)(j * 64) * NPROJ * 2; const char* vt = (const char*)(kvb + 2048) + (size_t)(j * 64) * NPROJ * 2;
                const bf16x8 k0 = *(const bf16x8*)(kt + goff), k1 = *(const bf16x8*)(kt + (size_t)32 * NPROJ * 2 + goff), v0 = *(const bf16x8*)(vt + goff), v1 = *(const bf16x8*)(vt + (size_t)32 * NPROJ * 2 + goff);
                *(bf16x8*)(K_lds + j * 16384 + kws) = k0; *(bf16x8*)(K_lds + j * 16384 + kws + 32 * 256) = k1;
                *(bf16x8*)(V_lds + j * 16384 + vst0) = v0; *(bf16x8*)(V_lds + j * 16384 + vst1) = v1; }
        }
        __syncthreads();
        const float slope = __builtin_amdgcn_exp2f(-(float)(h + 1));
        const float biasraw = slope * 11.313708498984761f;
        float* ws = (float*)(lds + RING_BYTES + 10240) + wid * 64; float* al_l = ws + 32; LAS int* rs = rowsid + wid * 32;
        const int vb0 = (int)(uintptr_t)V_lds + att::v_rd_base(ln);
        const int ntask = 8 + ((cnt + 31) >> 5);
        const int wstride = cvmode ? 4 : 8;
        if (cvmode && wid >= 4) { conv_wave(F, A, F.MISC + 20); continue; }
        for (int tk = wid; tk < ntask; tk += wstride) {
            const bool own = tk < 8; int pos, sid;
            if (own) { pos = n * 256 + tk * 32 + r32; sid = ((b * SEQ + pos) * 8 + h) * 4 + 3; }
            else { const int idx = (tk - 8) * 32 + r32; pos = 0; sid = PO_DUMP;
                   if (idx < cnt) { const int ent = WSP(int, WS_LIST)[(size_t)L * 8192 + idx]; pos = ent & 8191; sid = ((b * SEQ + pos) * 8 + h) * 4 + (ent >> 13); } }
            if (hi == 0) rs[r32] = sid;
            bf16x8 qr[8];
            { const bf16_t* qp = WSP(bf16_t, WS_P) + (size_t)(b * SEQ + pos) * NPROJ + h * 128 + hi * 8;
#pragma unroll
              for (int d0 = 0; d0 < 8; ++d0) qr[d0] = *(const bf16x8*)(qp + d0 * 16); }
            const int ntile = own ? (tk >> 1) + 1 : 4;
            const int qrel = pos - n * 256;
            f32x16 o[4]; float m_reg = -1e30f, l_reg = 0.f;
#pragma unroll
            for (int d = 0; d < 4; ++d) o[d] = f32x16{};
#define MB_STEP(J) do { if ((J) < ntile) { f32x16 p0, p1; SBAR(); att::qkt<128, J>(p0, p1, K_lds, r32, hi, qr);                     \
                { float br_ = biasraw; asm volatile("" : "+v"(br_)); const float bl = br_ * (float)((J) * 64 + 4 * hi);     \
                  _Pragma("unroll") for (int r = 0; r < 16; ++r) { const float bc = fmaf(br_, (float)((r & 3) + 8 * (r >> 2)), bl); p0[r] += bc; p1[r] += bc + 32.f * br_; } } \
                if (own && (J) * 64 + 63 > tk * 32) att::mask_tile(p0, p1, qrel - (J) * 64 - 4 * hi);                               \
                float mn, alpha; att::partialSM<128>(p0, p1, m_reg, mn, alpha);                                                     \
                if (__any(alpha < 1.f)) { if (hi == 0) al_l[r32] = alpha; asm volatile("s_waitcnt lgkmcnt(0)" ::: "memory");       \
                    _Pragma("unroll") for (int d_ = 0; d_ < 4; ++d_) _Pragma("unroll") for (int r = 0; r < 16; ++r) o[d_][r] *= al_l[att::crow(r, hi)]; } \
                bf16x8 pa0, pa1, pa2, pa3; att::finishSM(p0, p1, alpha, l_reg, pa0, pa1, pa2, pa3); SBAR();                         \
                att::pv_tile<J>(o, vb0, pa0, pa1, pa2, pa3); } } while (0)
            MB_STEP(0); MB_STEP(1); MB_STEP(2); MB_STEP(3);
#undef MB_STEP
            if (hi == 0) { ws[r32] = l_reg;
                WSP(float, WS_LSE)[sid] = m_reg * (1.4426950408889634f * 0.08838834764831845f) + __builtin_amdgcn_logf(l_reg) + slope * 1.4426950408889634f * (float)(n * 256 - pos); }
            LDS_WAIT();
            char* bb0 = lds + RING_BYTES + 12288 + wid * 512; char* bb1 = lds + RING_BYTES + 16384 + wid * 512;
#pragma unroll
            for (int r = 0; r < 16; ++r) { const int orow = att::crow(r, hi); const float rl = __builtin_amdgcn_rcpf(ws[orow]); const int os = rs[orow];
                char* bb = (r & 1) ? bb1 : bb0;
#pragma unroll
                for (int d0 = 0; d0 < 4; ++d0) { const float v = o[d0][r] * rl; const float vn = __shfl_xor(v, 1);
                    if ((r32 & 1) == 0) *(unsigned*)(bb + hi * 256 + d0 * 64 + r32 * 2) = cvt_pk_bf16(v, vn); }
                asm volatile("" ::: "memory");
                const u32x2 w = *(const u32x2*)(bb + hi * 256 + r32 * 8);
                asm volatile("" ::: "memory");
                *(u32x2*)((char*)(WSP(bf16_t, WS_PO) + (size_t)os * 128) + r32 * 8) = w; }
            LDS_WAIT();
        }
        if (cvmode && lane == 0) __hip_atomic_fetch_add((LAS unsigned*)(F.lds + MISC_OFF) + 20, 1u, __ATOMIC_RELAXED, __HIP_MEMORY_SCOPE_WORKGROUP);
    }
}

__device__ __forceinline__ void p5_combine(Frame& F, const Args& A) {
    const int lane = F.lane, h = lane >> 3, c0 = (lane & 7) * 16;
    for (int m = F.gw; m < T; m += F.NGW) {
        const int cur = (m & (SEQ - 1)) >> 8, nsel = cur < 3 ? cur : 3, sb = (m * 8 + h) * 4;
        float ls[4]; float M = -__builtin_inff();
#pragma unroll
        for (int s = 0; s < 4; ++s) { const bool valid = (s == 3) || (s < nsel); ls[s] = valid ? WSP(float, WS_LSE)[sb + s] : -__builtin_inff(); M = fmaxf(M, ls[s]); }
        float acc[16]; float wsum = 0.f;
#pragma unroll
        for (int j = 0; j < 16; ++j) acc[j] = 0.f;
#pragma unroll
        for (int s = 0; s < 4; ++s) { const bool valid = (s == 3) || (s < nsel);
            if (valid) { const float w = __builtin_amdgcn_exp2f(ls[s] - M); wsum += w; const bf16_t* p = WSP(bf16_t, WS_PO) + (size_t)(sb + s) * 128 + c0;
                const u32x4 a = *(const u32x4*)p, bq = *(const u32x4*)(p + 8);
                acc[0] += w * bflo(a.x); acc[1] += w * bfhi(a.x); acc[2] += w * bflo(a.y); acc[3] += w * bfhi(a.y); acc[4] += w * bflo(a.z); acc[5] += w * bfhi(a.z); acc[6] += w * bflo(a.w); acc[7] += w * bfhi(a.w);
                acc[8] += w * bflo(bq.x); acc[9] += w * bfhi(bq.x); acc[10] += w * bflo(bq.y); acc[11] += w * bfhi(bq.y); acc[12] += w * bflo(bq.z); acc[13] += w * bfhi(bq.z); acc[14] += w * bflo(bq.w); acc[15] += w * bfhi(bq.w); } }
        const float iw = 1.f / wsum; float ss = 0.f;
#pragma unroll
        for (int j = 0; j < 16; ++j) { acc[j] *= iw; ss += acc[j] * acc[j]; }
        const float rstd = 1.f / sqrtf(wave_sum(ss) * (1.f / 1024.f) + NORM_EPS);
        const float* g = IN_F(3) + h * 128 + c0; bf16_t* op = WSP(bf16_t, WS_OCAT) + (size_t)m * DM + h * 128 + c0;
#pragma unroll
        for (int q = 0; q < 2; ++q) { const f32x4 g0 = *(const f32x4*)(g + 8 * q), g1 = *(const f32x4*)(g + 8 * q + 4); u32x4 w;
            w.x = cvt_pk_bf16(acc[8 * q + 0] * rstd * g0.x, acc[8 * q + 1] * rstd * g0.y); w.y = cvt_pk_bf16(acc[8 * q + 2] * rstd * g0.z, acc[8 * q + 3] * rstd * g0.w);
            w.z = cvt_pk_bf16(acc[8 * q + 4] * rstd * g1.x, acc[8 * q + 5] * rstd * g1.y); w.w = cvt_pk_bf16(acc[8 * q + 6] * rstd * g1.z, acc[8 * q + 7] * rstd * g1.w);
            *(u32x4*)(op + 8 * q) = w; }
        bf16_t* mp = WSP(bf16_t, WS_OCAT) + (size_t)m * DM + 1024 + lane * 16; const u32x4 a = *(const u32x4*)mp, bq = *(const u32x4*)(mp + 8);
        float f[16] = {bflo(a.x), bfhi(a.x), bflo(a.y), bfhi(a.y), bflo(a.z), bfhi(a.z), bflo(a.w), bfhi(a.w), bflo(bq.x), bfhi(bq.x), bflo(bq.y), bfhi(bq.y), bflo(bq.z), bfhi(bq.z), bflo(bq.w), bfhi(bq.w)};
        float s2 = 0.f;
#pragma unroll
        for (int j = 0; j < 16; ++j) s2 += f[j] * f[j];
        const float rstd2 = 1.f / sqrtf(wave_sum(s2) * (1.f / 1024.f) + NORM_EPS);
        const float* g2 = IN_F(8) + lane * 16;
#pragma unroll
        for (int q = 0; q < 2; ++q) { const f32x4 g0 = *(const f32x4*)(g2 + 8 * q), g1 = *(const f32x4*)(g2 + 8 * q + 4); u32x4 w;
            w.x = cvt_pk_bf16(f[8 * q + 0] * rstd2 * g0.x, f[8 * q + 1] * rstd2 * g0.y); w.y = cvt_pk_bf16(f[8 * q + 2] * rstd2 * g0.z, f[8 * q + 3] * rstd2 * g0.w);
            w.z = cvt_pk_bf16(f[8 * q + 4] * rstd2 * g1.x, f[8 * q + 5] * rstd2 * g1.y); w.w = cvt_pk_bf16(f[8 * q + 6] * rstd2 * g1.z, f[8 * q + 7] * rstd2 * g1.w);
            *(u32x4*)(mp + 8 * q) = w; }
    }
}

__device__ __forceinline__ void p7_router(Frame& F, const Args& A) {
    const int tid = F.tid, lane = F.lane, wave = F.wave, r32 = lane & 31, hi = lane >> 5;
    LAS unsigned* hist = (LAS unsigned*)(F.lds + ROWSID_OFF); LAS unsigned* basel = hist + 32; LAS float* rstd_s = (LAS float*)(F.lds + ROWSID_OFF + 256);
    if (blockIdx.x == 0) { unsigned* z = (unsigned*)(WSP(unsigned char, WS_H2Q) + (size_t)T * DM); z[tid] = 0u; }
    for (int grp = blockIdx.x; grp < T / 64; grp += F.G) {
        {
            LAS float* part = (LAS float*)F.lds;
            const bf16_t* ap = WSP(bf16_t, WS_WR) + (size_t)r32 * DM + wave * 256 + hi * 8;
            const bf16_t* bp0 = WSP(bf16_t, WS_X1) + (size_t)(grp * 64 + r32) * DM + wave * 256 + hi * 8; const bf16_t* bp1 = bp0 + (size_t)32 * DM;
            f32x16 a0 = {}, a1 = {};
#pragma unroll
            for (int ks = 0; ks < 16; ++ks) { const bf16x8 af = *(const bf16x8*)(ap + ks * 16);
                a0 = __builtin_amdgcn_mfma_f32_32x32x16_bf16(af, *(const bf16x8*)(bp0 + ks * 16), a0, 0, 0, 0);
                a1 = __builtin_amdgcn_mfma_f32_32x32x16_bf16(af, *(const bf16x8*)(bp1 + ks * 16), a1, 0, 0, 0); }
#pragma unroll
            for (int r = 0; r < 16; ++r) { part[((wave * 2 + 0) * 16 + r) * 64 + lane] = a0[r]; part[((wave * 2 + 1) * 16 + r) * 64 + lane] = a1[r]; }
        }
        for (int j = 0; j < 8; ++j) { const int tl = wave * 8 + j, m = grp * 64 + tl;
            const u32x2* xr = (const u32x2*)(WSP(bf16_t, WS_X1) + (size_t)m * DM) + lane; const f32x4* gr = (const f32x4*)IN_F(10) + lane;
            f32x4 v[8]; float sq = 0.f;
#pragma unroll
            for (int q = 0; q < 8; ++q) { const u32x2 w = xr[64 * q]; v[q] = (f32x4){bflo(w.x), bfhi(w.x), bflo(w.y), bfhi(w.y)}; sq += (v[q].x * v[q].x + v[q].y * v[q].y) + (v[q].z * v[q].z + v[q].w * v[q].w); }
            const float rstd = 1.f / sqrtf(wave_sum(sq) * (1.f / DM) + NORM_EPS);
            unsigned* q4 = (unsigned*)(WSP(unsigned char, WS_H2Q) + (size_t)m * DM) + lane;
#pragma unroll
            for (int q = 0; q < 8; ++q) { const f32x4 gg = gr[64 * q]; const float s16 = rstd * 16.f; q4[64 * q] = pk4_fp8(v[q].x * s16 * gg.x, v[q].y * s16 * gg.y, v[q].z * s16 * gg.z, v[q].w * s16 * gg.w); }
            if (lane == 0) rstd_s[tl] = rstd; }
        if (tid < 32) hist[tid] = 0u;
        __syncthreads();
        int e_[4] = {0, 0, 0, 0}; float g_[4] = {0.f, 0.f, 0.f, 0.f}; unsigned pl_[4] = {0u, 0u, 0u, 0u};
        const int tok = grp * 64 + (wave & 1) * 32 + r32;
        if (wave < 2) {
            f32x16 acc = {};
            { const LAS float* part = (const LAS float*)F.lds;
#pragma unroll
              for (int w8 = 0; w8 < 8; ++w8)
#pragma unroll
                  for (int r = 0; r < 16; ++r) acc[r] += part[((w8 * 2 + wave) * 16 + r) * 64 + lane]; }
            const float rs = rstd_s[wave * 32 + r32];
            float v[16];
#pragma unroll
            for (int r = 0; r < 16; ++r) v[r] = acc[r] * rs + IN_F(12)[att::crow(r, hi)];
            const float NEG = -__builtin_inff();
            float cv[8]; int ci[8];
#pragma unroll
            for (int k = 0; k < 4; ++k) { float bv = NEG; int bi = 0;
#pragma unroll
                for (int r = 0; r < 16; ++r) if (v[r] > bv) { bv = v[r]; bi = r; }
#pragma unroll
                for (int r = 0; r < 16; ++r) if (r == bi) v[r] = NEG;
                cv[k] = bv; ci[k] = att::crow(bi, hi); }
#pragma unroll
            for (int k = 0; k < 4; ++k) { cv[4 + k] = __shfl_xor(cv[k], 32); ci[4 + k] = __shfl_xor(ci[k], 32); }
#pragma unroll
            for (int k = 0; k < 4; ++k) { float bv = NEG; int bi = 0, be = 1 << 30;
#pragma unroll
                for (int c = 0; c < 8; ++c) if (cv[c] > bv || (cv[c] == bv && ci[c] < be)) { bv = cv[c]; bi = c; be = ci[c]; }
#pragma unroll
                for (int c = 0; c < 8; ++c) if (c == bi) cv[c] = NEG;
                g_[k] = bv; e_[k] = be; }
            const float e1 = __expf(g_[1] - g_[0]), e2 = __expf(g_[2] - g_[0]), e3 = __expf(g_[3] - g_[0]), inv = 1.f / (1.f + e1 + e2 + e3);
            g_[0] = inv; g_[1] = e1 * inv; g_[2] = e2 * inv; g_[3] = e3 * inv;
            if (hi == 0) {
#pragma unroll
                for (int k = 0; k < 4; ++k) pl_[k] = __hip_atomic_fetch_add(hist + e_[k], 1u, __ATOMIC_RELAXED, __HIP_MEMORY_SCOPE_WORKGROUP); }
        }
        __syncthreads();
        if (tid < 32) { const unsigned c = hist[tid]; basel[tid] = c ? __hip_atomic_fetch_add(F.ctl + CW_ECNT + tid, c, RLX_AGENT) : 0u; }
        __syncthreads();
        if (wave < 2 && hi == 0) {
#pragma unroll
            for (int k = 0; k < 4; ++k) { const int e = e_[k]; const unsigned p = basel[e] + pl_[k];
                WSP(int, WS_ELIST)[(size_t)e * T + p] = tok; WSP(float, WS_EGATE)[(size_t)e * T + p] = g_[k]; WSP(int, WS_DEST)[tok * 4 + k] = e | (int)(p << 8); } }
        __syncthreads();
    }
}

__device__ __forceinline__ void moe_tables(Frame& F) {
    LAS int* tab = (LAS int*)(F.lds + TAB_OFF);
    if (F.tid < 32) { const int lane = F.tid; const int c = (int)__hip_atomic_load(F.ctl + CW_ECNT + lane, RLX_AGENT); const int nt = (c + 255) >> 8; int inc = nt;
#pragma unroll
        for (int o = 1; o < 32; o <<= 1) { const int v = __shfl_up(inc, o); if (lane >= o) inc += v; }
        const int tb = inc - nt; tab[640 + lane] = c; tab[672 + lane] = tb;
        for (int j = 0; j < nt; ++j) { tab[tb + j] = lane; tab[320 + tb + j] = j * 256; }
        if (lane == 31) tab[704] = inc; }
    __syncthreads();
}

__device__ __forceinline__ void p10_final(Frame& F, const Args& A) {
    const LAS int* tab = (const LAS int*)(F.lds + TAB_OFF); const int lane = F.lane;
    for (int m = F.gw; m < T; m += F.NGW) {
        const u32x2* xr = (const u32x2*)(WSP(bf16_t, WS_X1) + (size_t)m * DM) + lane;
        f32x4 v[8];
#pragma unroll
        for (int j = 0; j < 8; ++j) { const u32x2 w = xr[64 * j]; v[j] = (f32x4){bflo(w.x), bfhi(w.x), bflo(w.y), bfhi(w.y)}; }
#pragma unroll
        for (int k = 0; k < 4; ++k) { const int d = WSP(int, WS_DEST)[m * 4 + k], e = d & 255, p = d >> 8; const size_t row = (size_t)tab[672 + e] * 256 + p;
            const unsigned* yr = (const unsigned*)(WSP(unsigned char, WS_Y) + row * DM) + lane;
#pragma unroll
            for (int j = 0; j < 8; ++j) { const int w = (int)yr[64 * j]; const f32x2 lo = __builtin_amdgcn_cvt_pk_f32_fp8(w, false), hi2 = __builtin_amdgcn_cvt_pk_f32_fp8(w, true);
                v[j].x += lo.x * (1.f / 64.f); v[j].y += lo.y * (1.f / 64.f); v[j].z += hi2.x * (1.f / 64.f); v[j].w += hi2.y * (1.f / 64.f); } }
        float s = 0.f;
#pragma unroll
        for (int j = 0; j < 8; ++j) s += (v[j].x * v[j].x + v[j].y * v[j].y) + (v[j].z * v[j].z + v[j].w * v[j].w);
        const float rstd = 1.f / sqrtf(wave_sum(s) * (1.f / DM) + NORM_EPS);
        const f32x4* gr = (const f32x4*)IN_F(17) + lane; f32x4* o = (f32x4*)(A.out + (size_t)m * DM) + lane;
#pragma unroll
        for (int j = 0; j < 8; ++j) o[64 * j] = v[j] * rstd * gr[64 * j];
    }
}

__global__ void __launch_bounds__(NWAVES * 64, 2) fwd_kernel(Args args) {
    extern __shared__ __attribute__((aligned(16))) unsigned char lds_raw[];
    Frame F;
    F.lds = (LAS unsigned char*)lds_raw; F.ldsg = (char*)lds_raw;
    F.MISC = (volatile LAS unsigned*)(F.lds + MISC_OFF);
    F.tid = threadIdx.x; F.lane = F.tid & 63; F.wave = __builtin_amdgcn_readfirstlane(F.tid >> 6);
    F.G = gridDim.x; F.gw = blockIdx.x * NWAVES + F.wave; F.NGW = F.G * NWAVES;
    const Args& A = args;
    F.ctl = (unsigned*)(A.ws + WS_CTL);
    for (int u = F.tid; u < 64; u += NWAVES * 64) F.MISC[u] = 0u;
    __syncthreads();
    const int lo = args.ph_lo, hi = args.ph_hi;
    const bool one = (hi - lo) > 1;
    XcdBarrier bar; bar.bar = F.ctl + CW_BAR; bar.x = 0; bar.st = nullptr;
    if (one) bar = xcd_barrier_post(F.ctl + CW_BAR, F.MISC + 8);
#ifndef PROBE_DUP
#define PROBE_DUP 0
#endif
#ifndef PH_MASK
#define PH_MASK 0x7ff
#endif
#define IN(k) (((PH_MASK >> (k)) & 1) && lo <= (k) && (k) < hi)
#define SEAM(k) do { if (IN(k) && IN((k) + 1)) xcd_barrier(bar); } while (0)
    LAS int* tab = (LAS int*)(F.lds + TAB_OFF);

    if (IN(0)) { p0_prologue(F, A); if (PROBE_DUP & 1) { xcd_barrier(bar); p0_prologue(F, A); } SEAM(0); }
    if (IN(1)) { pg8::Gemm g{WSP(bf16_t, WS_XN), WSP(bf16_t, WS_WIN), T, 4096, DM}; pg8::StaticOrder S; S.init(T, 4096, F.G, (int)blockIdx.x); pg8::EpiBf16 E{WSP(bf16_t, WS_P), NPROJ};
        pg8::gemm_phase<pg8::EpiBf16, pg8::StaticOrder, false>(F.lds, g, S, E); SEAM(1); }
    if (IN(2)) { p2_thin(F, A); SEAM(2); }
    if (IN(3)) {
        { pg8::Gemm g{WSP(bf16_t, WS_CQN), WSP(bf16_t, WS_WUQ), T, QFW, 512}; pg8::StaticOrder S; S.init(T, QFW, F.G, (int)blockIdx.x); pg8::EpiQRope E{WSP(bf16_t, WS_QF), WSP(float, WS_ROPE)};
          pg8::gemm_phase<pg8::EpiQRope, pg8::StaticOrder, false>(F.lds, g, S, E); }
        { pg8::Gemm g{WSP(bf16_t, WS_CKVN), WSP(bf16_t, WS_WUKV), T, KVW, 512}; pg8::StaticOrder S; S.init(T, KVW, F.G, (int)blockIdx.x); pg8::EpiBf16 E{WSP(bf16_t, WS_KV), KVW};
          pg8::gemm_phase<pg8::EpiBf16, pg8::StaticOrder, false>(F.lds, g, S, E); }
        p3_gating(F, A); SEAM(3); }
    if (IN(4)) { p4_setup(F);
        if (((blockIdx.x >> 3) & 1) == 0) {
            p4_moba_loop(F, A, 0, true); if (F.wave >= 4) conv_wave(F, A); __syncthreads(); }
        p4_mla_loop(F, A, 0);
        conv_wave(F, A); SEAM(4); }
    if (IN(5)) { p5_combine(F, A); SEAM(5); }
    if (IN(6)) { pg8::Gemm g{WSP(bf16_t, WS_OCAT), WSP(bf16_t, WS_WO), T, DM, DM}; pg8::StaticOrder S; S.init(T, DM, F.G, (int)blockIdx.x); pg8::EpiResBf16 E{IN_F(0), WSP(bf16_t, WS_X1)};
        pg8::gemm_phase<pg8::EpiResBf16, pg8::StaticOrder, false>(F.lds, g, S, E); SEAM(6); }
    if (IN(7)) { p7_router(F, A); SEAM(7); }
    if (IN(8)) { moe_tables(F);
        pg8::MoeOrder S; S.nM = tab[704]; S.nN = 2 * FF / 256; S.G = F.G; S.c = (int)blockIdx.x; S.tile_e = tab; S.tile_r0 = tab + 320; S.ecnt = tab + 640; S.elist = WSP(int, WS_ELIST); S.estride = (size_t)2 * FF * DM / 2;
        pg8::Gemm g{WSP(bf16_t, WS_H2Q), WSP(bf16_t, WS_W1), S.nM * 256, 2 * FF, DM / 2}; pg8::EpiSwiglu E{WSP(unsigned char, WS_ACT), IN_F(14), (LAS float*)(F.lds + PRE_OFF)};
        pg8::gemm_phase<pg8::EpiSwiglu, pg8::MoeOrder, true, true>(F.lds, g, S, E); SEAM(8); }
    if (IN(9)) { if (!IN(8)) moe_tables(F);
        pg8::MoeOrder S; S.nM = tab[704]; S.nN = DM / 256; S.G = F.G; S.c = (int)blockIdx.x; S.tile_e = tab; S.tile_r0 = tab + 320; S.ecnt = tab + 640; S.elist = WSP(int, WS_ELIST); S.estride = (size_t)DM * FF / 2;
        pg8::Gemm g{WSP(bf16_t, WS_ACT), WSP(bf16_t, WS_W2), S.nM * 256, DM, FF / 2}; pg8::EpiDown E{WSP(unsigned char, WS_Y), IN_F(16), WSP(float, WS_EGATE), tab + 640, (LAS float*)(F.lds + PRE_OFF)};
        pg8::gemm_phase<pg8::EpiDown, pg8::MoeOrder, false, true>(F.lds, g, S, E); SEAM(9); }
    if (IN(10)) { if (!IN(8)) moe_tables(F); p10_final(F, A); }
#undef IN
#undef SEAM
}

constexpr int NPH = 11;
extern "C" void kernel_launch(void* const* d_in, const int* in_sizes, int n_in, void* d_out, int out_size, void* d_ws, size_t ws_size, hipStream_t stream) {
    static int grid = 0;
    if (grid == 0) {
        if (n_in != 18 || out_size != T * DM || ws_size < WS_END) { fprintf(stderr, "kernel_launch: unexpected shapes (n_in %d out %d ws %zu need %zu)\n", n_in, out_size, ws_size, (size_t)WS_END); grid = -1; return; }
        int dev = 0, cus = 0, per_cu = 0;
        if (hipGetDevice(&dev) != hipSuccess || hipDeviceGetAttribute(&cus, hipDeviceAttributeMultiprocessorCount, dev) != hipSuccess) { grid = -1; return; }
        if (hipFuncSetAttribute((const void*)fwd_kernel, hipFuncAttributeMaxDynamicSharedMemorySize, LDS_BYTES) != hipSuccess) { fprintf(stderr, "kernel_launch: hipFuncSetAttribute failed\n"); grid = -1; return; }
        if (hipOccupancyMaxActiveBlocksPerMultiprocessor(&per_cu, (const void*)fwd_kernel, NWAVES * 64, LDS_BYTES) != hipSuccess || per_cu < 1)
            fprintf(stderr, "kernel_launch: occupancy query reports %d workgroups per CU\n", per_cu);
        (void)hipGetLastError();
        grid = cus;
    }
    if (grid < 0) return;
    (void)hipMemsetAsync((char*)d_ws + WS_CTL, 0, CTL_ZERO_BYTES, stream);
    Args a{};
    for (int i = 0; i < 18; ++i) a.in[i] = (const float*)d_in[i];
    a.out = (float*)d_out; a.ws = (unsigned char*)d_ws;
#if MK_N_LAUNCHES == 1
    a.ph_lo = 0; a.ph_hi = NPH;
    hipLaunchKernelGGL(fwd_kernel, dim3(grid), dim3(NWAVES * 64), LDS_BYTES, stream, a);
#else
    for (int p = 0; p < NPH; ++p) { a.ph_lo = p; a.ph_hi = p + 1; hipLaunchKernelGGL(fwd_kernel, dim3(grid), dim3(NWAVES * 64), LDS_BYTES, stream, a); }
#endif
}
```
